# Optimizing an MI355X kernel written in HIP

```python
import math
import jax
import jax.numpy as jnp
from jax import lax
import numpy as np

D_MODEL = 1024
BATCH = 1
SEQ = 16384
DEPTH = 2
DEC_BATCH = 32
DEC_SEQ = 1
PAST_LEN = 16384
PAGE_SIZE = 128

N_EVEN = (DEPTH + 1) // 2
N_ODD = DEPTH // 2
S5_WIDTH = D_MODEL // 2
S5_GROUP = 16
S5_GROUPS = S5_WIDTH // S5_GROUP
S5_STATE = 64
SGU_WIDTH = D_MODEL // 2
SGU_HEADS = 4
SGU_HEAD_DIM = SGU_WIDTH // SGU_HEADS
CHUNK = 128
EVEN_IN = S5_WIDTH + 2 * SGU_WIDTH
HEAD_DIM = 64
N_HEADS = D_MODEL // HEAD_DIM
ROT_DIM = HEAD_DIM // 4
ROPE_THETA = 500000.0
DIL_BRANCHES = ((128, 1), (512, 4), (2048, 16))
BAND = 128
WIN_MAX = 2048
D_FF = ((8 * D_MODEL // 3 + 127) // 128) * 128
CONV_W = 3
EPS = 1e-6
NEG_INF = -1e30

kernel_name = 'hybrid_s5_sgu_dilated_attn_decoder_step'


def rms_norm(x, g):
    x32 = x.astype(jnp.float32)
    y = x32 * lax.rsqrt(jnp.mean(x32 * x32, axis=-1, keepdims=True) + EPS)
    return (y * g.astype(jnp.float32)).astype(x.dtype)


def ada_modulation(c, w, b):
    mod = jax.nn.silu(c) @ w + b
    return jnp.split(mod[:, None, :], 6, axis=-1)


def partial_rope(x, pos):
    half = ROT_DIM // 2
    inv = jnp.power(ROPE_THETA, -jnp.arange(half, dtype=jnp.float32) * 2.0 / ROT_DIM)
    ang = pos.astype(jnp.float32)[:, None] * inv[None, :]
    cos = jnp.cos(ang)[None, :, None, :]
    sin = jnp.sin(ang)[None, :, None, :]
    x32 = x.astype(jnp.float32)
    x1 = x32[..., :half]
    x2 = x32[..., half:ROT_DIM]
    out = jnp.concatenate([x1 * cos - x2 * sin, x1 * sin + x2 * cos, x32[..., ROT_DIM:]], axis=-1)
    return out.astype(x.dtype)


def s5_mixer(xa, h0_re, h0_im, lam_re, lam_im, log_dt, b_re, b_im, c_re, c_im, d_skip, w_glu, b_glu):
    f32 = jnp.float32
    bsz, L, _ = xa.shape
    u = xa.astype(f32).reshape(bsz, L, S5_GROUPS, S5_GROUP)
    dt = jnp.exp(log_dt.astype(f32))[:, None]
    lr = lam_re.astype(f32)
    li = lam_im.astype(f32)
    mag = jnp.exp(lr * dt)
    ar = mag * jnp.cos(li * dt)
    ai = mag * jnp.sin(li * dt)
    den = lr * lr + li * li
    fr = ((ar - 1.0) * lr + ai * li) / den
    fi = (ai * lr - (ar - 1.0) * li) / den
    br = b_re.astype(f32)
    bi = b_im.astype(f32)
    bbr = fr[..., None] * br - fi[..., None] * bi
    bbi = fr[..., None] * bi + fi[..., None] * br
    ur = jnp.einsum('blgp,gnp->blgn', u, bbr)
    ui = jnp.einsum('blgp,gnp->blgn', u, bbi)
    h0r = h0_re.astype(f32)
    h0i = h0_im.astype(f32)
    ur = ur.at[:, 0].add(ar * h0r - ai * h0i)
    ui = ui.at[:, 0].add(ar * h0i + ai * h0r)

    def combine(e1, e2):
        a1r, a1i, b1r, b1i = e1
        a2r, a2i, b2r, b2i = e2
        return (a2r * a1r - a2i * a1i, a2r * a1i + a2i * a1r,
                a2r * b1r - a2i * b1i + b2r, a2r * b1i + a2i * b1r + b2i)

    _, _, hr, hi = lax.associative_scan(
        combine, (jnp.broadcast_to(ar, ur.shape), jnp.broadcast_to(ai, ur.shape), ur, ui), axis=1)
    y = (jnp.einsum('blgn,gpn->blgp', hr, c_re.astype(f32))
         - jnp.einsum('blgn,gpn->blgp', hi, c_im.astype(f32))
         + d_skip.astype(f32).reshape(S5_GROUPS, S5_GROUP) * u)
    y = jax.nn.gelu(y.reshape(bsz, L, S5_WIDTH))
    out = y * jax.nn.sigmoid(y @ w_glu.astype(f32) + b_glu.astype(f32))
    return out.astype(xa.dtype), hr[:, -1].astype(h0_re.dtype), hi[:, -1].astype(h0_im.dtype)


def sgu_mixer(u, v, ln_g, ln_b, w_s, b_s):
    bsz, L, _ = v.shape
    v32 = v.astype(jnp.float32)
    mu = jnp.mean(v32, axis=-1, keepdims=True)
    var = jnp.mean(jnp.square(v32 - mu), axis=-1, keepdims=True)
    vn = ((v32 - mu) * lax.rsqrt(var + EPS) * ln_g.astype(jnp.float32) + ln_b.astype(jnp.float32)).astype(v.dtype)
    Lp = -(-L // CHUNK) * CHUNK
    vc = jnp.pad(vn, ((0, 0), (0, Lp - L), (0, 0))).reshape(bsz, Lp // CHUNK, CHUNK, SGU_HEADS, SGU_HEAD_DIM)
    causal = jnp.tril(jnp.ones((CHUNK, CHUNK), dtype=w_s.dtype))
    s = jnp.einsum('hij,bcjhe->bcihe', w_s * causal[None], vc) + b_s.T[None, None, :, :, None]
    s = s.reshape(bsz, Lp, SGU_WIDTH)[:, :L]
    return u * s, vn


def dilated_band(q, k, v, d):
    f32 = jnp.float32
    bsz, L, H, E = q.shape
    span = BAND * d
    Lp = -(-L // span) * span
    nb = Lp // span

    def to_sub(t):
        t = jnp.pad(t.astype(f32), ((0, 0), (0, Lp - L), (0, 0), (0, 0)))
        t = t.reshape(bsz, Lp // d, d, H, E).transpose(0, 2, 1, 3, 4)
        return t.reshape(bsz, d, nb, BAND, H, E)

    def with_prev(t):
        prev = jnp.concatenate([jnp.zeros_like(t[:, :, :1]), t[:, :, :-1]], axis=2)
        return jnp.concatenate([prev, t], axis=3)

    qb = to_sub(q)
    kk = with_prev(to_sub(k))
    vv = with_prev(to_sub(v))
    s = jnp.einsum('brnqhe,brnkhe->brnhqk', qb, kk) * (HEAD_DIM ** -0.5)
    i = jnp.arange(BAND)[:, None]
    j = jnp.arange(2 * BAND)[None, :]
    band = (j >= i) & (j <= i + BAND)
    mask = band[None] & ((jnp.arange(nb)[:, None, None] > 0) | (j >= BAND)[None])
    s = jnp.where(mask[None, None, :, None], s, NEG_INF)
    m = jnp.max(s, axis=-1)
    p = jnp.exp(s - m[..., None])
    den = jnp.sum(p, axis=-1)
    m = m.transpose(0, 1, 2, 4, 3)
    den = den.transpose(0, 1, 2, 4, 3)
    o = jnp.einsum('brnhqk,brnkhe->brnqhe', p, vv) / den[..., None]

    def from_sub(t):
        t = t.reshape((bsz, d, Lp // d) + t.shape[4:])
        t = jnp.moveaxis(t, 1, 2)
        t = t.reshape((bsz, Lp) + t.shape[3:])
        return t[:, :L]

    return from_sub(o), from_sub(m), from_sub(den)


def dilated_gather(q, k_all, v_all, window, d, n_past):
    f32 = jnp.float32
    Lq = q.shape[1]
    n_k = window // d + 1
    idx = n_past + jnp.arange(Lq)[:, None] - d * jnp.arange(n_k)[None, :]
    valid = idx >= 0
    idx = jnp.maximum(idx, 0)
    kg = k_all[:, idx].astype(f32)
    vg = v_all[:, idx].astype(f32)
    s = jnp.einsum('bqhe,bqkhe->bqhk', q.astype(f32), kg) * (HEAD_DIM ** -0.5)
    s = jnp.where(valid[None, :, None, :], s, NEG_INF)
    m = jnp.max(s, axis=-1)
    p = jnp.exp(s - m[..., None])
    den = jnp.sum(p, axis=-1)
    o = jnp.einsum('bqhk,bqkhe->bqhe', p, vg) / den[..., None]
    return o, m, den


def merge_branches(parts):
    o = jnp.stack([pt[0] for pt in parts])
    m = jnp.stack([pt[1] for pt in parts])
    den = jnp.stack([pt[2] for pt in parts])
    w = den * jnp.exp(m - jnp.max(m, axis=0, keepdims=True))
    return jnp.sum(w[..., None] * o, axis=0) / jnp.sum(w, axis=0)[..., None]


def conv_ffn(h, buf, w_up, conv_w, conv_b, w_down):
    L = h.shape[1]
    up = h @ w_up
    a = up[..., :D_FF]
    g = up[..., D_FF:]
    xa = jnp.concatenate([buf.astype(a.dtype), a], axis=1)
    y = conv_b
    for tap in range(CONV_W):
        y = y + conv_w[tap] * xa[:, tap:tap + L]
    out = (jax.nn.gelu(y) * g) @ w_down
    return out, xa[:, L:]


def trunk(x, c, is_prompt, s5_re0, s5_im0, ck, cv, conv0, p):
    bsz, L, _ = x.shape
    pos = jnp.arange(L, dtype=jnp.int32) + (0 if is_prompt else PAST_LEN)
    s5r, s5i, vrows, ks, vs, convs = [], [], [], [], [], []
    for layer in range(DEPTH):
        sh1, sc1, g1, sh2, sc2, g2 = ada_modulation(c, p['ada_w'][layer], p['ada_b'][layer])
        h = rms_norm(x, p['norm_g'][layer, 0]) * (1 + sc1) + sh1
        if layer % 2 == 0:
            e = layer // 2
            proj = h @ p['ev_w_in'][e]
            xa = proj[..., :S5_WIDTH]
            u = jax.nn.gelu(proj[..., S5_WIDTH:S5_WIDTH + SGU_WIDTH])
            v = jax.nn.gelu(proj[..., S5_WIDTH + SGU_WIDTH:])
            a_out, hr, hi = s5_mixer(xa, s5_re0[e], s5_im0[e], p['s5_lam_re'][e], p['s5_lam_im'][e],
                                     p['s5_log_dt'][e], p['s5_b_re'][e], p['s5_b_im'][e], p['s5_c_re'][e],
                                     p['s5_c_im'][e], p['s5_d'][e], p['s5_w_glu'][e], p['s5_b_glu'][e])
            b_out, vn = sgu_mixer(u, v, p['sg_ln_g'][e], p['sg_ln_b'][e], p['sg_w'][e], p['sg_b'][e])
            mix = jnp.concatenate([a_out, b_out], axis=-1) @ p['ev_w_out'][e]
            s5r.append(hr)
            s5i.append(hi)
            vrows.append(vn)
        else:
            o_i = layer // 2
            qkv = (h @ p['od_w_qkv'][o_i]).reshape(bsz, L, 3, N_HEADS, HEAD_DIM)
            q = partial_rope(qkv[:, :, 0], pos)
            k = partial_rope(qkv[:, :, 1], pos)
            v = qkv[:, :, 2]
            if is_prompt:
                parts = [dilated_band(q, k, v, d) for (_, d) in DIL_BRANCHES]
                keep = min(WIN_MAX, L)
                ks.append(k[:, L - keep:])
                vs.append(v[:, L - keep:])
            else:
                n_past = ck.shape[2]
                k_all = jnp.concatenate([ck[o_i].astype(k.dtype), k], axis=1)
                v_all = jnp.concatenate([cv[o_i].astype(v.dtype), v], axis=1)
                parts = [dilated_gather(q, k_all, v_all, w, d, n_past) for (w, d) in DIL_BRANCHES]
                ks.append(k)
                vs.append(v)
            att = merge_branches(parts).astype(x.dtype)
            mix = att.reshape(bsz, L, N_HEADS * HEAD_DIM) @ p['od_w_o'][o_i]
        x = x + g1 * mix
        h = rms_norm(x, p['norm_g'][layer, 1]) * (1 + sc2) + sh2
        ff, buf = conv_ffn(h, conv0[layer], p['ffn_w_up'][layer], p['ffn_conv_w'][layer],
                           p['ffn_conv_b'][layer], p['ffn_w_down'][layer])
        convs.append(buf)
        x = x + g2 * ff
    y = rms_norm(x, p['final_g'])
    return y, jnp.stack(s5r), jnp.stack(s5i), jnp.stack(vrows), jnp.stack(ks), jnp.stack(vs), jnp.stack(convs)


def setup_inputs(seed: int = 0) -> dict:
    key = jax.random.key(seed)
    ks = iter(jax.random.split(key, 48))
    f32 = jnp.float32

    def nrm(shape, scale=1.0):
        return jax.random.normal(next(ks), shape, f32) * scale

    buf_len = min(WIN_MAX, PAST_LEN)
    inp = {}
    inp['x_prompt'] = nrm((BATCH, SEQ, D_MODEL))
    inp['x_sample'] = nrm((DEC_BATCH, DEC_SEQ, D_MODEL))
    inp['c_prompt'] = nrm((BATCH, D_MODEL))
    inp['c_sample'] = nrm((DEC_BATCH, D_MODEL))
    inp['state_s5_re'] = nrm((N_EVEN, DEC_BATCH, S5_GROUPS, S5_STATE), 0.3)
    inp['state_s5_im'] = nrm((N_EVEN, DEC_BATCH, S5_GROUPS, S5_STATE), 0.3)
    inp['cache_c_k'] = nrm((N_ODD, DEC_BATCH, buf_len, N_HEADS, HEAD_DIM))
    inp['cache_c_v'] = nrm((N_ODD, DEC_BATCH, buf_len, N_HEADS, HEAD_DIM))
    inp['state_ffn_conv'] = nrm((DEPTH, DEC_BATCH, CONV_W - 1, D_FF))
    inp['ada_w'] = nrm((DEPTH, D_MODEL, 6 * D_MODEL), 0.5 * D_MODEL ** -0.5)
    inp['ada_b'] = nrm((DEPTH, 6 * D_MODEL), 0.01)
    inp['norm_g'] = 1.0 + nrm((DEPTH, 2, D_MODEL), 0.01)
    inp['final_g'] = 1.0 + nrm((D_MODEL,), 0.01)
    inp['ev_w_in'] = nrm((N_EVEN, D_MODEL, EVEN_IN), D_MODEL ** -0.5)
    inp['ev_w_out'] = nrm((N_EVEN, S5_WIDTH + SGU_WIDTH, D_MODEL), (S5_WIDTH + SGU_WIDTH) ** -0.5)
    inp['s5_lam_re'] = -0.5 + nrm((N_EVEN, S5_GROUPS, S5_STATE), 0.01)
    inp['s5_lam_im'] = math.pi * jnp.arange(S5_STATE, dtype=f32) + nrm((N_EVEN, S5_GROUPS, S5_STATE), 0.01)
    inp['s5_log_dt'] = jax.random.uniform(next(ks), (N_EVEN, S5_GROUPS), f32, math.log(1e-3), math.log(1e-1))
    inp['s5_b_re'] = nrm((N_EVEN, S5_GROUPS, S5_STATE, S5_GROUP), (2 * S5_GROUP) ** -0.5)
    inp['s5_b_im'] = nrm((N_EVEN, S5_GROUPS, S5_STATE, S5_GROUP), (2 * S5_GROUP) ** -0.5)
    inp['s5_c_re'] = nrm((N_EVEN, S5_GROUPS, S5_GROUP, S5_STATE), (2 * S5_STATE) ** -0.5)
    inp['s5_c_im'] = nrm((N_EVEN, S5_GROUPS, S5_GROUP, S5_STATE), (2 * S5_STATE) ** -0.5)
    inp['s5_d'] = nrm((N_EVEN, S5_WIDTH))
    inp['s5_w_glu'] = nrm((N_EVEN, S5_WIDTH, S5_WIDTH), S5_WIDTH ** -0.5)
    inp['s5_b_glu'] = nrm((N_EVEN, S5_WIDTH), 0.01)
    inp['sg_ln_g'] = 1.0 + nrm((N_EVEN, SGU_WIDTH), 0.01)
    inp['sg_ln_b'] = nrm((N_EVEN, SGU_WIDTH), 0.01)
    inp['sg_w'] = nrm((N_EVEN, SGU_HEADS, CHUNK, CHUNK), CHUNK ** -0.5)
    inp['sg_b'] = 1.0 + nrm((N_EVEN, SGU_HEADS, CHUNK), 0.01)
    inp['od_w_qkv'] = nrm((N_ODD, D_MODEL, 3 * N_HEADS * HEAD_DIM), D_MODEL ** -0.5)
    inp['od_w_o'] = nrm((N_ODD, N_HEADS * HEAD_DIM, D_MODEL), (N_HEADS * HEAD_DIM) ** -0.5)
    inp['ffn_w_up'] = nrm((DEPTH, D_MODEL, 2 * D_FF), D_MODEL ** -0.5)
    inp['ffn_conv_w'] = nrm((DEPTH, CONV_W, D_FF), CONV_W ** -0.5)
    inp['ffn_conv_b'] = nrm((DEPTH, D_FF), 0.01)
    inp['ffn_w_down'] = nrm((DEPTH, D_FF, D_MODEL), D_FF ** -0.5)
    return inp


def reference(x_prompt, x_sample, c_prompt, c_sample, state_s5_re, state_s5_im, cache_c_k, cache_c_v,
              state_ffn_conv, ada_w, ada_b, norm_g, final_g, ev_w_in, ev_w_out, s5_lam_re, s5_lam_im,
              s5_log_dt, s5_b_re, s5_b_im, s5_c_re, s5_c_im, s5_d, s5_w_glu, s5_b_glu, sg_ln_g, sg_ln_b,
              sg_w, sg_b, od_w_qkv, od_w_o, ffn_w_up, ffn_conv_w, ffn_conv_b, ffn_w_down):
    params = dict(ada_w=ada_w, ada_b=ada_b, norm_g=norm_g, final_g=final_g, ev_w_in=ev_w_in,
                  ev_w_out=ev_w_out, s5_lam_re=s5_lam_re, s5_lam_im=s5_lam_im, s5_log_dt=s5_log_dt,
                  s5_b_re=s5_b_re, s5_b_im=s5_b_im, s5_c_re=s5_c_re, s5_c_im=s5_c_im, s5_d=s5_d,
                  s5_w_glu=s5_w_glu, s5_b_glu=s5_b_glu, sg_ln_g=sg_ln_g, sg_ln_b=sg_ln_b, sg_w=sg_w,
                  sg_b=sg_b, od_w_qkv=od_w_qkv, od_w_o=od_w_o, ffn_w_up=ffn_w_up, ffn_conv_w=ffn_conv_w,
                  ffn_conv_b=ffn_conv_b, ffn_w_down=ffn_w_down)
    bp = x_prompt.shape[0]
    zero_s5 = jnp.zeros((N_EVEN, bp, S5_GROUPS, S5_STATE), x_prompt.dtype)
    zero_conv = jnp.zeros((DEPTH, bp, CONV_W - 1, D_FF), x_prompt.dtype)
    y_prompt, s5_re_p, s5_im_p, _, k_p, v_p, conv_p = trunk(
        x_prompt, c_prompt, True, zero_s5, zero_s5, None, None, zero_conv, params)
    y_sample, s5_re_s, s5_im_s, sgu_v_s, k_s, v_s, conv_s = trunk(
        x_sample, c_sample, False, state_s5_re, state_s5_im, cache_c_k, cache_c_v, state_ffn_conv, params)
    return (y_prompt, y_sample, s5_re_p, s5_im_p, s5_re_s, s5_im_s, sgu_v_s, k_p, v_p, k_s, v_s, conv_p, conv_s)
```

```cpp
#include <hip/hip_runtime.h>
#include <hip/hip_cooperative_groups.h>
#include <cstdio>
#include <cstdint>
namespace pg8 {
#define PG8_LAS __attribute__((address_space(3)))
typedef unsigned short bf16_t;
typedef short bf16x8 __attribute__((ext_vector_type(8)));
typedef float f32x4 __attribute__((ext_vector_type(4)));
typedef unsigned u32x4 __attribute__((ext_vector_type(4)));
constexpr int BM = 256, BK = 64, HALF = 128, HTB = HALF * BK * 2  , STAGE_BYTES = 8 * HTB, NXCD = 8, WGM = 8;

__host__ __device__ __forceinline__ int lds_byte(int r, int c) { const int st = (r >> 4) * 2 + (c >> 5), rr = r & 15, cc = c & 31, ob = rr * 64 + cc * 2; return st * 1024 + (ob ^ (((ob >> 9) & 1) << 5)); }
__host__ __device__ __forceinline__ void stage_rc(int b, int& R, int& C) { const int st = b / 1024, sb = b % 1024, swz = sb ^ (((sb >> 9) & 1) << 5); R = (st >> 1) * 16 + swz / 64; C = (st & 1) * 32 + (swz % 64) / 2; }
__host__ __device__ __forceinline__ int perm32(int rho) { const int n = rho >> 4, i = rho & 15; return 8 * (i >> 2) + 4 * n + (i & 3); }

struct Unit { int pm, pn; };
struct Gemm { const bf16_t* A; const bf16_t* Bt; int M, N, K; };

struct StaticOrder {
    int nM, nN, nwg, G, c;
    __host__ __device__ void init(int M, int N, int G_, int c_) { nM = M / BM; nN = N / BM; nwg = nM * nN; G = G_; c = c_; }
    __host__ __device__ bool next(int i, Unit& u) const {
        const long L = (long)i * G + c; if (L >= nwg) return false;
        int wgid = (int)L; { const int q = nwg / NXCD, r = nwg % NXCD, xcd = wgid % NXCD, off = wgid / NXCD; wgid = (xcd < r ? xcd * (q + 1) : r * (q + 1) + (xcd - r) * q) + off; }
        const int nig = WGM * nN, gid = wgid / nig, fm = gid * WGM, gsz = (nM - fm) < WGM ? (nM - fm) : WGM;
        u.pm = fm + ((wgid % nig) % gsz); u.pn = (wgid % nig) / gsz; return true;
    }
    __device__ __forceinline__ void a_ready(const Unit&) const {}
    __device__ __forceinline__ void done(const Unit&) const {}
};

__device__ __forceinline__ unsigned cvt_pk_bf16(float lo, float hi) { unsigned r; asm volatile("v_cvt_pk_bf16_f32 %0, %1, %2" : "=v"(r) : "v"(lo), "v"(hi)); return r; }
typedef float f32x2 __attribute__((ext_vector_type(2)));
__device__ __forceinline__ float gelu_tanh(float x) {
    const float u = x * (1.5957691216f + 0.0713548163f * x * x);
    return x / (1.0f + __expf(-u));
}
__device__ __forceinline__ float sigmoidf_(float x) { return 1.0f / (1.0f + __expf(-x)); }
__device__ __forceinline__ float bf2f(unsigned short b) { return __uint_as_float(((unsigned)b) << 16); }

struct EpiStore {
    static constexpr bool PERM = true, AFTER_DRAIN = false;
    bf16_t* O; int ldc; int gelu_from;
    __device__ __forceinline__ void operator()(const f32x4 (&acc)[2][2][4][2], const Unit& u, int wr, int wc, int fr, int fq) const {
        const int row0 = u.pm * BM + wr * 64 + fr, col0 = u.pn * BM + wc * 32 + 8 * fq;
        const bool act = (u.pn * BM) >= gelu_from;
#pragma unroll
        for (int ai = 0; ai < 2; ++ai)
#pragma unroll
            for (int m = 0; m < 4; ++m) { bf16_t* rowp = O + (size_t)(row0 + ai * HALF + m * 16) * ldc + col0;
#pragma unroll
                for (int bj = 0; bj < 2; ++bj) { f32x4 v0 = acc[ai][bj][m][0], v1 = acc[ai][bj][m][1];
                    if (act) {
#pragma unroll
                        for (int e = 0; e < 4; ++e) { v0[e] = gelu_tanh(v0[e]); v1[e] = gelu_tanh(v1[e]); } }
                    u32x4 w; w.x = cvt_pk_bf16(v0[0], v0[1]); w.y = cvt_pk_bf16(v0[2], v0[3]); w.z = cvt_pk_bf16(v1[0], v1[1]); w.w = cvt_pk_bf16(v1[2], v1[3]);
                    *(u32x4*)(rowp + bj * HALF) = w; } }
    }
};
struct EpiGlu {
    static constexpr bool PERM = true, AFTER_DRAIN = false;
    bf16_t* O; int ldc; const bf16_t* Y; int ldy; const float* bias;
    __device__ __forceinline__ void operator()(const f32x4 (&acc)[2][2][4][2], const Unit& u, int wr, int wc, int fr, int fq) const {
        const int row0 = u.pm * BM + wr * 64 + fr, col0 = u.pn * BM + wc * 32 + 8 * fq;
#pragma unroll
        for (int ai = 0; ai < 2; ++ai)
#pragma unroll
            for (int m = 0; m < 4; ++m) { const size_t r = (size_t)(row0 + ai * HALF + m * 16);
#pragma unroll
                for (int bj = 0; bj < 2; ++bj) { const int c = col0 + bj * HALF;
                    const f32x4 b0 = *(const f32x4*)(bias + c), b1 = *(const f32x4*)(bias + c + 4);
                    const u32x4 yw = *(const u32x4*)(Y + r * ldy + c);
                    f32x4 v0 = acc[ai][bj][m][0] + b0, v1 = acc[ai][bj][m][1] + b1;
                    float y[8]; y[0] = __uint_as_float(yw.x << 16); y[1] = __uint_as_float(yw.x & 0xffff0000u); y[2] = __uint_as_float(yw.y << 16); y[3] = __uint_as_float(yw.y & 0xffff0000u);
                    y[4] = __uint_as_float(yw.z << 16); y[5] = __uint_as_float(yw.z & 0xffff0000u); y[6] = __uint_as_float(yw.w << 16); y[7] = __uint_as_float(yw.w & 0xffff0000u);
#pragma unroll
                    for (int e = 0; e < 4; ++e) { v0[e] = y[e] * sigmoidf_(v0[e]); v1[e] = y[4 + e] * sigmoidf_(v1[e]); }
                    u32x4 w; w.x = cvt_pk_bf16(v0[0], v0[1]); w.y = cvt_pk_bf16(v0[2], v0[3]); w.z = cvt_pk_bf16(v1[0], v1[1]); w.w = cvt_pk_bf16(v1[2], v1[3]);
                    *(u32x4*)(O + r * ldc + c) = w; } }
    }
};
struct EpiResid {
    static constexpr bool PERM = false, AFTER_DRAIN = false;
    float* X; const float* gate; int gstride; int lp; int mvalid;
    __device__ __forceinline__ void operator()(const f32x4 (&acc)[2][2][4][2], const Unit& u, int wr, int wc, int fr, int fq) const {
        const int row0 = u.pm * BM + wr * 64 + fr, col0 = u.pn * BM + wc * 32 + 4 * fq;
#pragma unroll
        for (int ai = 0; ai < 2; ++ai)
#pragma unroll
            for (int m = 0; m < 4; ++m) { const int r = row0 + ai * HALF + m * 16;
                if (r < mvalid) { const int mrow = r < lp ? 0 : (r - lp + 1); const float* gp = gate + (size_t)mrow * gstride; float* xp = X + (size_t)r * 1024;
#pragma unroll
                    for (int bj = 0; bj < 2; ++bj)
#pragma unroll
                        for (int n = 0; n < 2; ++n) { const int c = col0 + bj * HALF + n * 16; const f32x4 g = *(const f32x4*)(gp + c); f32x4 x = *(const f32x4*)(xp + c); x = x + g * acc[ai][bj][m][n]; *(f32x4*)(xp + c) = x; } } }
    }
};
template <class Epi, class Sched, bool ALIGN_EPI = false, bool SP2 = false>
__device__ __forceinline__ void gemm_phase(PG8_LAS unsigned char* lds, const Gemm g, const Sched& S, const Epi& E) {
    const int tid = threadIdx.x, wid = __builtin_amdgcn_readfirstlane(tid >> 6), lane = tid & 63, wr = wid >> 2, wc = wid & 3, fr = lane & 15, fq = lane >> 4;
    const int K = g.K, nt = K / BK;
    unsigned voffA[2], voffB[2];
#pragma unroll
    for (int i = 0; i < 2; ++i) { int R, C; stage_rc(tid * 16 + i * 8192, R, C); const int Rb = Epi::PERM ? ((R & ~31) + perm32(R & 31)) : R;
        voffA[i] = (unsigned)(R * K + C) * 2u; voffB[i] = (unsigned)(Rb * K + C) * 2u; }
    const size_t kstep = (size_t)(BK * 2);
    const size_t hstep = (size_t)HALF * K * 2;
    const size_t tstep = 2 * hstep;
    const unsigned ldsw = (unsigned)wid * 1024u;
    const int aoff = lds_byte(wr * 64 + fr, fq * 8), boff = lds_byte(wc * 32 + fr, fq * 8);
#define PG8_SA(b, h) (((b) * 2 + (h)) * HTB)
#define PG8_SB(b, h) ((4 + (b) * 2 + (h)) * HTB)
#define PG8_STAGE(bufoff, gbase, voff) do { _Pragma("unroll") for (int _i = 0; _i < 2; ++_i) \
        __builtin_amdgcn_global_load_lds((const unsigned*)((const char*)(gbase) + (voff)[_i]), (PG8_LAS unsigned*)(lds + (bufoff) + ldsw + _i * 8192), 16, 0, 0); } while (0)
#define PG8_LDA(dst, b, h) do { _Pragma("unroll") for (int m = 0; m < 4; ++m) _Pragma("unroll") for (int k = 0; k < 2; ++k) dst[m][k] = *(const PG8_LAS bf16x8*)(lds + PG8_SA(b, h) + aoff + m * 2048 + k * 1024); } while (0)
#define PG8_LDB(dst, b, h) do { _Pragma("unroll") for (int n = 0; n < 2; ++n) _Pragma("unroll") for (int k = 0; k < 2; ++k) dst[n][k] = *(const PG8_LAS bf16x8*)(lds + PG8_SB(b, h) + boff + n * 2048 + k * 1024); } while (0)
#define PG8_MMA(ai, bj, At, Bt) do { __builtin_amdgcn_s_setprio(1); _Pragma("unroll") for (int m = 0; m < 4; ++m) _Pragma("unroll") for (int n = 0; n < 2; ++n) _Pragma("unroll") for (int k = 0; k < 2; ++k) \
        acc[ai][bj][m][n] = __builtin_amdgcn_mfma_f32_16x16x32_bf16(Bt[n][k], At[m][k], acc[ai][bj][m][n], 0, 0, 0); __builtin_amdgcn_s_setprio(0); } while (0)
#define PG8_WAIT_V(n) asm volatile("s_waitcnt vmcnt(" #n ")" ::: "memory")
#define PG8_WAIT_L(n) asm volatile("s_waitcnt lgkmcnt(" #n ")" ::: "memory")
#define PG8_BAR __builtin_amdgcn_s_barrier()
#define PG8_SCHED __builtin_amdgcn_sched_barrier(0)
    Unit cur, nxt; int ui = 0;
    if (!S.next(0, cur)) return;
    f32x4 acc[2][2][4][2];
#pragma unroll
    for (int a = 0; a < 2; ++a)
#pragma unroll
        for (int b = 0; b < 2; ++b)
#pragma unroll
            for (int m = 0; m < 4; ++m)
#pragma unroll
                for (int n = 0; n < 2; ++n) acc[a][b][m][n] = (f32x4){0.f, 0.f, 0.f, 0.f};
    bf16x8 At[4][2], B0[2][2], B1[2][2];
    const char* cA = (const char*)g.A + (size_t)cur.pm * tstep; const char* cB = (const char*)g.Bt + (size_t)cur.pn * tstep;
    S.a_ready(cur);
    if constexpr (SP2) {
        PG8_STAGE(PG8_SB(0, 0), cB, voffB); PG8_STAGE(PG8_SB(0, 1), cB + hstep, voffB); PG8_STAGE(PG8_SA(0, 0), cA, voffA); PG8_STAGE(PG8_SA(0, 1), cA + hstep, voffA);
        if (wr == 1) PG8_BAR;
        PG8_WAIT_V(2); PG8_BAR;
        PG8_STAGE(PG8_SB(1, 0), cB + kstep, voffB); PG8_STAGE(PG8_SA(1, 0), cA + kstep, voffA); PG8_STAGE(PG8_SB(1, 1), cB + hstep + kstep, voffB);
        PG8_WAIT_V(6); PG8_BAR;
    } else {
        PG8_STAGE(PG8_SB(0, 0), cB, voffB); PG8_STAGE(PG8_SA(0, 0), cA, voffA); PG8_STAGE(PG8_SB(0, 1), cB + hstep, voffB); PG8_STAGE(PG8_SA(0, 1), cA + hstep, voffA);
        if (wr == 1) PG8_BAR;
        PG8_WAIT_V(4); PG8_BAR;
        PG8_STAGE(PG8_SB(1, 0), cB + kstep, voffB); PG8_STAGE(PG8_SA(1, 0), cA + kstep, voffA); PG8_STAGE(PG8_SB(1, 1), cB + hstep + kstep, voffB);
        PG8_WAIT_V(6); PG8_BAR;
    }
    for (;;) {
        const bool has_next = S.next(ui + 1, nxt);
        const char* nA = has_next ? (const char*)g.A + (size_t)nxt.pm * tstep : cA; const char* nB = has_next ? (const char*)g.Bt + (size_t)nxt.pn * tstep : cB;
        for (int t = 0; t < nt; t += 2) {
            const bool last = (t == nt - 2);
            const char* a1 = cA + (size_t)(t + 1) * kstep;
            const char* a2 = last ? nA : cA + (size_t)(t + 2) * kstep; const char* b2 = last ? nB : cB + (size_t)(t + 2) * kstep;
            const char* a3 = a2 + kstep; const char* b3 = b2 + kstep;
            if (last && has_next) S.a_ready(nxt);
            if constexpr (SP2) {
            PG8_LDB(B0, 0, 0); PG8_LDB(B1, 0, 1); PG8_SCHED; PG8_LDA(At, 0, 0); PG8_STAGE(PG8_SA(1, 1), a1 + hstep, voffA);
            PG8_WAIT_V(8); PG8_WAIT_L(0); PG8_BAR; PG8_MMA(0, 0, At, B0); PG8_MMA(0, 1, At, B1); PG8_BAR; PG8_SCHED;
            PG8_LDA(At, 0, 1); PG8_STAGE(PG8_SB(0, 0), b2, voffB); PG8_STAGE(PG8_SB(0, 1), b2 + hstep, voffB); PG8_STAGE(PG8_SA(0, 0), a2, voffA);
            PG8_WAIT_V(8); PG8_WAIT_L(0); PG8_BAR; PG8_MMA(1, 0, At, B0); PG8_MMA(1, 1, At, B1); PG8_BAR; PG8_SCHED;
            PG8_LDB(B0, 1, 0); PG8_LDB(B1, 1, 1); PG8_SCHED; PG8_LDA(At, 1, 0); PG8_STAGE(PG8_SA(0, 1), a2 + hstep, voffA);
            PG8_WAIT_V(8); PG8_WAIT_L(0); PG8_BAR; PG8_MMA(0, 0, At, B0); PG8_MMA(0, 1, At, B1); PG8_BAR; PG8_SCHED;
            PG8_LDA(At, 1, 1); PG8_STAGE(PG8_SB(1, 0), b3, voffB); PG8_STAGE(PG8_SB(1, 1), b3 + hstep, voffB); PG8_STAGE(PG8_SA(1, 0), a3, voffA);
            PG8_WAIT_V(8); PG8_WAIT_L(0); PG8_BAR; PG8_MMA(1, 0, At, B0); PG8_MMA(1, 1, At, B1); PG8_BAR; PG8_SCHED;
            } else {
            PG8_LDB(B0, 0, 0); PG8_SCHED; PG8_LDA(At, 0, 0); PG8_STAGE(PG8_SA(1, 1), a1 + hstep, voffA);
            PG8_WAIT_L(8); PG8_BAR; PG8_WAIT_L(0); PG8_MMA(0, 0, At, B0); PG8_BAR; PG8_SCHED;
            PG8_LDB(B1, 0, 1); PG8_STAGE(PG8_SB(0, 0), b2, voffB);
            PG8_BAR; PG8_WAIT_L(0); PG8_MMA(0, 1, At, B1); PG8_BAR;
            PG8_LDA(At, 0, 1); PG8_STAGE(PG8_SA(0, 0), a2, voffA);
            PG8_BAR; PG8_WAIT_L(0); PG8_MMA(1, 0, At, B0); PG8_BAR; PG8_SCHED;
            PG8_STAGE(PG8_SB(0, 1), b2 + hstep, voffB);
            PG8_WAIT_V(6); PG8_BAR; PG8_MMA(1, 1, At, B1); PG8_BAR;
            PG8_LDB(B0, 1, 0); PG8_SCHED; PG8_LDA(At, 1, 0); PG8_STAGE(PG8_SA(0, 1), a2 + hstep, voffA);
            PG8_WAIT_L(8); PG8_BAR; PG8_WAIT_L(0); PG8_MMA(0, 0, At, B0); PG8_BAR; PG8_SCHED;
            PG8_LDB(B1, 1, 1); PG8_STAGE(PG8_SB(1, 0), b3, voffB);
            PG8_BAR; PG8_WAIT_L(0); PG8_MMA(0, 1, At, B1); PG8_BAR;
            PG8_LDA(At, 1, 1); PG8_STAGE(PG8_SA(1, 0), a3, voffA);
            PG8_BAR; PG8_WAIT_L(0); PG8_MMA(1, 0, At, B0); PG8_BAR; PG8_SCHED;
            PG8_STAGE(PG8_SB(1, 1), b3 + hstep, voffB);
            PG8_WAIT_V(6); PG8_BAR; PG8_MMA(1, 1, At, B1); PG8_BAR;
            }
        }
        if constexpr (ALIGN_EPI) { if (wr == 0) PG8_BAR; }
        if constexpr (!Epi::AFTER_DRAIN) { E(acc, cur, wr, wc, fr, fq); S.done(cur); }
        if (!has_next) break;
#pragma unroll
        for (int a = 0; a < 2; ++a)
#pragma unroll
            for (int b = 0; b < 2; ++b)
#pragma unroll
                for (int m = 0; m < 4; ++m)
#pragma unroll
                    for (int n = 0; n < 2; ++n) acc[a][b][m][n] = (f32x4){0.f, 0.f, 0.f, 0.f};
        cur = nxt; cA = nA; cB = nB; ++ui;
        if constexpr (ALIGN_EPI) { if (wr == 1) PG8_BAR; }
    }
    PG8_WAIT_V(0);
    if constexpr (!ALIGN_EPI) { if (wr == 0) PG8_BAR; }
    PG8_BAR;
    if constexpr (Epi::AFTER_DRAIN) { E.fused(acc, cur, wr, wc, fr, fq, lds, wid, lane); S.done(cur); }
#undef PG8_SA
#undef PG8_SB
#undef PG8_STAGE
#undef PG8_LDA
#undef PG8_LDB
#undef PG8_MMA
#undef PG8_WAIT_V
#undef PG8_WAIT_L
#undef PG8_BAR
#undef PG8_SCHED
}
}
namespace cg = cooperative_groups;
#define LAS __attribute__((address_space(3)))
typedef unsigned short bf16;
typedef float f32x4 __attribute__((ext_vector_type(4)));
typedef unsigned u32x4 __attribute__((ext_vector_type(4)));
typedef unsigned u32x2 __attribute__((ext_vector_type(2)));

typedef short bf16x8v __attribute__((ext_vector_type(8)));
typedef short s16x4v __attribute__((ext_vector_type(4)));

constexpr int DM = 1024, LP = 16384, NS = 32, MV = LP + NS, MT = 16640;
constexpr int EIN = 1536, DFF = 2816, UPN = 5632, QKVN = 3072;
constexpr int NG = 32, NST = 64;
constexpr int CH = 128, NCH = LP / CH;
constexpr int MODROW = 6144, MODL = 33 * MODROW;
constexpr float EPS = 1e-6f;

enum { I_XP = 0, I_XS, I_CP, I_CS, I_S5RE, I_S5IM, I_CK, I_CV, I_CONV, I_ADAW, I_ADAB, I_NORMG, I_FING, I_WIN, I_WOUT, I_LAMRE, I_LAMIM, I_LOGDT, I_BRE, I_BIM, I_CRE, I_CIM,
       I_S5D, I_WGLU, I_BGLU, I_LNG, I_LNB, I_SGW, I_SGB, I_WQKV, I_WO, I_WUP, I_CONVW, I_CONVB, I_WDN, N_IN };
constexpr size_t O_YP = 0, O_YS = 16777216, O_S5RP = 16809984, O_S5IP = 16812032, O_S5RS = 16814080, O_S5IS = 16879616, O_SGUV = 16945152, O_KP = 16961536, O_VP = 19058688,
                 O_KS = 21155840, O_VS = 21188608, O_CONVP = 21221376, O_CONVS = 21232640, O_TOTAL = 21593088;
constexpr size_t MiB = 1u << 20;
constexpr size_t WS_CTL = 0, WS_WIN = 1 * MiB, WS_WGLU = 4 * MiB, WS_WOUT = 5 * MiB, WS_WQKV = 7 * MiB, WS_WO = 13 * MiB, WS_WUP0 = 15 * MiB, WS_WUP1 = 26 * MiB, WS_WDN0 = 37 * MiB,
                 WS_WDN1 = 43 * MiB, WS_MOD = 49 * MiB, WS_S5A = 51 * MiB, WS_S5BB = 52 * MiB, WS_KTAB = 53 * MiB, WS_ETAB = 54 * MiB, WS_G1 = 56 * MiB, WS_X = 64 * MiB, WS_H = 130 * MiB, WS_PROJ = 164 * MiB,
                 WS_Y = 214 * MiB, WS_MIX = 232 * MiB, WS_UP = 266 * MiB, WS_ACT = 446 * MiB, WS_QKV = 537 * MiB, WS_ATT = 636 * MiB, WS_SBUF = 670 * MiB, WS_HCAT = 686 * MiB, WS_END = 694 * MiB;
constexpr int LDS_BYTES = 147456;
constexpr int NPHASE = 22;

struct Params { const float* in[N_IN]; float* out; unsigned char* ws; int ph_lo, ph_hi; };

__device__ __forceinline__ unsigned f2bf(float f) { unsigned u = __builtin_bit_cast(unsigned, f); return (u + 0x7fffu + ((u >> 16) & 1u)) >> 16; }
__device__ __forceinline__ unsigned pk2(float lo, float hi) { return f2bf(lo) | (f2bf(hi) << 16); }
__device__ __forceinline__ float bflo(unsigned w) { return __uint_as_float(w << 16); }
__device__ __forceinline__ float bfhi(unsigned w) { return __uint_as_float(w & 0xffff0000u); }
__device__ __forceinline__ void unpack8(const u32x4 w, float (&f)[8]) { f[0] = bflo(w.x); f[1] = bfhi(w.x); f[2] = bflo(w.y); f[3] = bfhi(w.y); f[4] = bflo(w.z); f[5] = bfhi(w.z); f[6] = bflo(w.w); f[7] = bfhi(w.w); }
__device__ __forceinline__ float wave_sum(float v) {
#pragma unroll
    for (int o = 1; o < 64; o <<= 1) v += __shfl_xor(v, o);
    return v;
}
__device__ __forceinline__ float wave_max(float v) {
#pragma unroll
    for (int o = 1; o < 64; o <<= 1) v = fmaxf(v, __shfl_xor(v, o));
    return v;
}
__device__ __forceinline__ void sincos_red(float ang, float& s, float& c) {
    const double a = (double)ang; const double n = __builtin_rint(a * 0.15915494309189535); const float r = (float)(a - n * 6.283185307179586);
    s = __sinf(r); c = __cosf(r);
}
__device__ __forceinline__ float gelu_t(float x) { return pg8::gelu_tanh(x); }

__device__ __forceinline__ void s5_disc(const Params& P, int chn, float& ar, float& ai, float& fr, float& fi) {
    const float dt = expf(P.in[I_LOGDT][chn >> 6]), lr = P.in[I_LAMRE][chn], li = P.in[I_LAMIM][chn];
    const float mag = expf(lr * dt); float sn, cs; sincos_red(li * dt, sn, cs);
    ar = mag * cs; ai = mag * sn; const float den = lr * lr + li * li;
    fr = ((ar - 1.0f) * lr + ai * li) / den; fi = (ai * lr - (ar - 1.0f) * li) / den;
}
__device__ __forceinline__ void transpose_item(const float* W, int K, int N, bf16* WT, LAS float* scr, int item, int lane) {
    const int nblk = N / 32, kb = item / nblk, nb = item % nblk, k0 = 64 * kb, n0 = 32 * nb;
    float tv[32];
#pragma unroll
    for (int i = 0; i < 32; ++i) tv[i] = W[(size_t)(k0 + 2 * i + (lane >> 5)) * N + n0 + (lane & 31)];
#pragma unroll
    for (int i = 0; i < 32; ++i) scr[(2 * i + (lane >> 5)) * 33 + (lane & 31)] = tv[i];
    asm volatile("s_waitcnt lgkmcnt(0)" ::: "memory");
    const int c = lane & 7;
#pragma unroll
    for (int j = 0; j < 4; ++j) { const int n = (lane >> 3) + 8 * j; const LAS float* s = scr + (8 * c) * 33 + n;
        u32x4 o; o.x = pk2(s[0 * 33], s[1 * 33]); o.y = pk2(s[2 * 33], s[3 * 33]); o.z = pk2(s[4 * 33], s[5 * 33]); o.w = pk2(s[6 * 33], s[7 * 33]);
        *(u32x4*)(WT + (size_t)(n0 + n) * K + k0 + 8 * c) = o; }
    asm volatile("s_waitcnt lgkmcnt(0)" ::: "memory");
}
__device__ __forceinline__ void phase_prep(const Params& P, LAS unsigned char* lds, int tid, int lane, int wave) {
    unsigned char* ws = P.ws;
    {
        LAS float* scr = (LAS float*)(lds + wave * 16384);
        const int gw = blockIdx.x * 8 + wave, NGW = gridDim.x * 8;
        constexpr int I_IN = 16 * 48, I_GLU = 8 * 16, I_OUT = 16 * 32, I_QKV = 16 * 96, I_O = 16 * 32, I_UP = 16 * 176, I_DN = 44 * 32;
        constexpr int NITEMS = I_IN + I_GLU + I_OUT + I_QKV + I_O + 2 * I_UP + 2 * I_DN;
        for (int it = gw; it < NITEMS; it += NGW) {
            int r = it;
            if (r < I_IN) { transpose_item(P.in[I_WIN], 1024, EIN, (bf16*)(ws + WS_WIN), scr, r, lane); continue; } r -= I_IN;
            if (r < I_GLU) { transpose_item(P.in[I_WGLU], 512, 512, (bf16*)(ws + WS_WGLU), scr, r, lane); continue; } r -= I_GLU;
            if (r < I_OUT) { transpose_item(P.in[I_WOUT], 1024, 1024, (bf16*)(ws + WS_WOUT), scr, r, lane); continue; } r -= I_OUT;
            if (r < I_QKV) { transpose_item(P.in[I_WQKV], 1024, QKVN, (bf16*)(ws + WS_WQKV), scr, r, lane); continue; } r -= I_QKV;
            if (r < I_O) { transpose_item(P.in[I_WO], 1024, 1024, (bf16*)(ws + WS_WO), scr, r, lane); continue; } r -= I_O;
            if (r < I_UP) { transpose_item(P.in[I_WUP], 1024, UPN, (bf16*)(ws + WS_WUP0), scr, r, lane); continue; } r -= I_UP;
            if (r < I_UP) { transpose_item(P.in[I_WUP] + (size_t)1024 * UPN, 1024, UPN, (bf16*)(ws + WS_WUP1), scr, r, lane); continue; } r -= I_UP;
            if (r < I_DN) { transpose_item(P.in[I_WDN], DFF, 1024, (bf16*)(ws + WS_WDN0), scr, r, lane); continue; } r -= I_DN;
            transpose_item(P.in[I_WDN] + (size_t)DFF * 1024, DFF, 1024, (bf16*)(ws + WS_WDN1), scr, r, lane);
        }
    }
    __syncthreads();
    for (int unit = blockIdx.x; unit < 196 + 192; unit += gridDim.x) {
        if (unit < 192) {
            const int layer = unit / 96, col0 = (unit % 96) * 64;
            LAS float* sc = (LAS float*)lds;
            for (int idx = tid; idx < 33 * 1024; idx += 512) { const int row = idx >> 10, k = idx & 1023; const float c = row == 0 ? P.in[I_CP][k] : P.in[I_CS][(row - 1) * 1024 + k]; sc[idx] = c / (1.0f + __expf(-c)); }
            __syncthreads();
            float acc[33];
#pragma unroll
            for (int r = 0; r < 33; ++r) acc[r] = 0.f;
            const float* W = P.in[I_ADAW] + (size_t)layer * 1024 * MODROW + col0 + lane;
#pragma unroll 4
            for (int k = wave * 128; k < wave * 128 + 128; k += 4) { const float w0 = W[(size_t)k * MODROW], w1 = W[(size_t)(k + 1) * MODROW], w2 = W[(size_t)(k + 2) * MODROW], w3 = W[(size_t)(k + 3) * MODROW];
#pragma unroll
                for (int r = 0; r < 33; ++r) { const f32x4 s4 = *(const LAS f32x4*)(sc + r * 1024 + k); acc[r] += (s4.x * w0 + s4.y * w1) + (s4.z * w2 + s4.w * w3); } }
            __syncthreads();
            LAS float* part = (LAS float*)lds;
#pragma unroll
            for (int r = 0; r < 33; ++r) part[(wave * 33 + r) * 64 + lane] = acc[r];
            __syncthreads();
            for (int o = tid; o < 33 * 64; o += 512) { const int r = o >> 6, l = o & 63; float s = P.in[I_ADAB][layer * MODROW + col0 + l];
#pragma unroll
                for (int w = 0; w < 8; ++w) s += part[(w * 33 + r) * 64 + l];
                ((float*)(ws + WS_MOD))[(size_t)layer * MODL + r * MODROW + col0 + l] = s; }
            __syncthreads();
        } else if (unit < 196) {
            const int chn = (unit - 192) * 512 + tid;
            float ar, ai, fr, fi; s5_disc(P, chn, ar, ai, fr, fi);
            float* A2 = (float*)(ws + WS_S5A); A2[2 * chn] = ar; A2[2 * chn + 1] = ai;
            float pr = ar, pi = ai;
#pragma unroll
            for (int i = 0; i < 4; ++i) { const float nr = pr * pr - pi * pi, ni = 2.0f * pr * pi; pr = nr; pi = ni; }
            A2[4096 + 2 * chn] = pr; A2[4096 + 2 * chn + 1] = pi;
#pragma unroll
            for (int i = 0; i < 4; ++i) { const float nr = pr * pr - pi * pi, ni = 2.0f * pr * pi; pr = nr; pi = ni; }
            A2[8192 + 2 * chn] = pr; A2[8192 + 2 * chn + 1] = pi;
            float* BB = (float*)(ws + WS_S5BB) + (size_t)chn * 32;
#pragma unroll
            for (int p = 0; p < 16; ++p) { const float br = P.in[I_BRE][chn * 16 + p], bi = P.in[I_BIM][chn * 16 + p]; BB[p] = fr * br - fi * bi; BB[16 + p] = fr * bi + fi * br; }
        } else if (unit < 196 + 64) {
            const int id = (unit - 196) * 512 + tid, nq = id & 3, q = (id >> 2) & 15, p = (id >> 6) & 15, g = id >> 10;
            LAS float* la = (LAS float*)lds;
            LAS float* lb = la + 128;
            LAS float* lc = lb + 2048;
            if (tid < 64) { float ar, ai, fr, fi; s5_disc(P, g * 64 + tid, ar, ai, fr, fi); la[2 * tid] = ar; la[2 * tid + 1] = ai; la[4224 + 2 * tid] = fr; la[4224 + 2 * tid + 1] = fi; }
            __syncthreads();
#pragma unroll
            for (int it = 0; it < 2; ++it) { const int e = tid + 512 * it, n = e >> 4; const float br = P.in[I_BRE][(size_t)g * 1024 + e], bi = P.in[I_BIM][(size_t)g * 1024 + e], fr = la[4224 + 2 * n], fi = la[4224 + 2 * n + 1];
                lb[2 * e] = fr * br - fi * bi; lb[2 * e + 1] = fr * bi + fi * br;
                lc[2 * e] = P.in[I_CRE][(size_t)g * 1024 + e]; lc[2 * e + 1] = P.in[I_CIM][(size_t)g * 1024 + e]; }
            __syncthreads();
            float acc[16];
#pragma unroll
            for (int t = 0; t < 16; ++t) acc[t] = 0.f;
            for (int nn = 0; nn < 16; ++nn) { const int n = nq * 16 + nn;
                const float ar = la[2 * n], ai = la[2 * n + 1], bbr = lb[2 * (n * 16 + q)], bbi = lb[2 * (n * 16 + q) + 1], cr = lc[2 * (p * 64 + n)], ci = lc[2 * (p * 64 + n) + 1];
                float wr = cr * bbr - ci * bbi, wi = cr * bbi + ci * bbr;
#pragma unroll
                for (int t = 0; t < 16; ++t) { acc[t] += wr; const float nr = wr * ar - wi * ai, ni = wr * ai + wi * ar; wr = nr; wi = ni; } }
#pragma unroll
            for (int t = 0; t < 16; ++t) { acc[t] += __shfl_xor(acc[t], 1); acc[t] += __shfl_xor(acc[t], 2); }
            if (nq == 0) { acc[0] += (p == q) ? P.in[I_S5D][g * 16 + p] : 0.f; bf16* KT = (bf16*)(ws + WS_KTAB);
#pragma unroll
                for (int t = 0; t < 16; ++t) KT[((size_t)(g * 16 + t) * 16 + p) * 16 + q] = (bf16)f2bf(acc[t]); }
            __syncthreads();
        } else if (unit < 196 + 128) {
            const int id = (unit - 260) * 512 + tid, n = id & 63, p = (id >> 6) & 15, g = id >> 10, chn = g * 64 + n;
            float ar, ai, fr, fi; s5_disc(P, chn, ar, ai, fr, fi);
            const float cr = P.in[I_CRE][(size_t)(g * 16 + p) * 64 + n], ci = P.in[I_CIM][(size_t)(g * 16 + p) * 64 + n];
            float wr = cr * ar - ci * ai, wi = cr * ai + ci * ar; bf16* ET = (bf16*)(ws + WS_ETAB);
#pragma unroll
            for (int j = 0; j < 16; ++j) { bf16* e = ET + ((size_t)(g * 16 + j) * 16 + p) * 128; e[n] = (bf16)f2bf(wr); e[64 + n] = (bf16)f2bf(-wi);
                const float nr = wr * ar - wi * ai, ni = wr * ai + wi * ar; wr = nr; wi = ni; }
        } else {
            const int id = (unit - 324) * 512 + tid, q = id & 15, n = (id >> 4) & 63, g = id >> 10, chn = g * 64 + n;
            float ar, ai, fr, fi; s5_disc(P, chn, ar, ai, fr, fi);
            const float br = P.in[I_BRE][chn * 16 + q], bi = P.in[I_BIM][chn * 16 + q]; float wr = fr * br - fi * bi, wi = fr * bi + fi * br;
            bf16* G1 = (bf16*)(ws + WS_G1);
#pragma unroll
            for (int t = 0; t < 16; ++t) { const int i = 15 - t; G1[((size_t)(g * 128 + n)) * 256 + i * 16 + q] = (bf16)f2bf(wr); G1[((size_t)(g * 128 + 64 + n)) * 256 + i * 16 + q] = (bf16)f2bf(wi);
                const float nr = wr * ar - wi * ai, ni = wr * ai + wi * ar; wr = nr; wi = ni; }
        }
    }
}

template <bool FIRST> __device__ __forceinline__ void phase_norm(const Params& P, int layer, int which, int lane, int wave) {
    unsigned char* ws = P.ws; float* X = (float*)(ws + WS_X); bf16* H = (bf16*)(ws + WS_H);
    const float* g = P.in[I_NORMG] + (layer * 2 + which) * 1024; const float* MOD = (const float*)(ws + WS_MOD) + (size_t)layer * MODL;
    const int shoff = which ? 3 * 1024 : 0, scoff = which ? 4 * 1024 : 1024;
    const int gw = blockIdx.x * 8 + wave, NGW = gridDim.x * 8;
    for (int r0 = 4 * gw; r0 < MV; r0 += 4 * NGW) {
        f32x4 v[4][4]; float ss[4];
#pragma unroll
        for (int a = 0; a < 4; ++a) { const int r = r0 + a;
            const float* src = FIRST ? (r < LP ? P.in[I_XP] + (size_t)r * 1024 : P.in[I_XS] + (size_t)(r - LP) * 1024) : X + (size_t)r * 1024;
#pragma unroll
            for (int j = 0; j < 4; ++j) v[a][j] = ((const f32x4*)src + lane)[64 * j]; }
#pragma unroll
        for (int a = 0; a < 4; ++a) { float t = 0.f;
#pragma unroll
            for (int j = 0; j < 4; ++j) t += (v[a][j].x * v[a][j].x + v[a][j].y * v[a][j].y) + (v[a][j].z * v[a][j].z + v[a][j].w * v[a][j].w);
            ss[a] = t; }
#pragma unroll
        for (int o = 1; o < 64; o <<= 1) {
#pragma unroll
            for (int a = 0; a < 4; ++a) ss[a] += __shfl_xor(ss[a], o); }
#pragma unroll
        for (int a = 0; a < 4; ++a) { const int r = r0 + a; const float rstd = rsqrtf(ss[a] * (1.0f / 1024.0f) + EPS);
            const float* mod = MOD + (size_t)(r < LP ? 0 : r - LP + 1) * MODROW; u32x2* ho = (u32x2*)(H + (size_t)r * 1024) + lane;
#pragma unroll
            for (int j = 0; j < 4; ++j) { const int col = 4 * (lane + 64 * j);
                const f32x4 gg = *(const f32x4*)(g + col), sc = *(const f32x4*)(mod + scoff + col), sh = *(const f32x4*)(mod + shoff + col);
                const f32x4 o = v[a][j] * rstd * gg * (sc + 1.0f) + sh;
                ho[64 * j] = (u32x2){pg8::cvt_pk_bf16(o.x, o.y), pg8::cvt_pk_bf16(o.z, o.w)};
                if (FIRST) ((f32x4*)(X + (size_t)r * 1024) + lane)[64 * j] = v[a][j]; } }
    }
}
__device__ __forceinline__ void phase_final_norm(const Params& P, int lane, int wave) {
    const float* X = (const float*)(P.ws + WS_X); const float* g = P.in[I_FING];
    const int gw = blockIdx.x * 8 + wave, NGW = gridDim.x * 8;
    for (int r0 = 4 * gw; r0 < MV; r0 += 4 * NGW) {
        f32x4 v[4][4]; float ss[4];
#pragma unroll
        for (int a = 0; a < 4; ++a)
#pragma unroll
            for (int j = 0; j < 4; ++j) v[a][j] = ((const f32x4*)(X + (size_t)(r0 + a) * 1024) + lane)[64 * j];
#pragma unroll
        for (int a = 0; a < 4; ++a) { float t = 0.f;
#pragma unroll
            for (int j = 0; j < 4; ++j) t += (v[a][j].x * v[a][j].x + v[a][j].y * v[a][j].y) + (v[a][j].z * v[a][j].z + v[a][j].w * v[a][j].w);
            ss[a] = t; }
#pragma unroll
        for (int o = 1; o < 64; o <<= 1) {
#pragma unroll
            for (int a = 0; a < 4; ++a) ss[a] += __shfl_xor(ss[a], o); }
#pragma unroll
        for (int a = 0; a < 4; ++a) { const int r = r0 + a; const float rstd = rsqrtf(ss[a] * (1.0f / 1024.0f) + EPS);
            float* orow = r < LP ? P.out + O_YP + (size_t)r * 1024 : P.out + O_YS + (size_t)(r - LP) * 1024;
#pragma unroll
            for (int j = 0; j < 4; ++j) { const int col = 4 * (lane + 64 * j); const f32x4 gg = *(const f32x4*)(g + col); ((f32x4*)orow + lane)[64 * j] = v[a][j] * rstd * gg; } }
    }
}

__device__ __forceinline__ void sgu_unit(const Params& P, LAS unsigned char* lds, int c, int h, int tid, int lane, int wave) {
    const bf16* PROJ = (const bf16*)(P.ws + WS_PROJ); bf16* MIX = (bf16*)(P.ws + WS_MIX);
    LAS unsigned char* vnb = lds;
    LAS unsigned char* wb = lds + 32768;
    LAS float* stat = (LAS float*)(lds + 65536);
    const int R0 = c * CH;
    { u32x4 wv[16];
#pragma unroll
      for (int rr = 0; rr < 16; ++rr) wv[rr] = *(const u32x4*)(PROJ + (size_t)(R0 + wave * 16 + rr) * EIN + 1024 + lane * 8);
#pragma unroll
      for (int rr = 0; rr < 16; ++rr) { const int row = wave * 16 + rr; float x[8]; unpack8(wv[rr], x);
        float s = 0.f;
#pragma unroll
        for (int k = 0; k < 8; ++k) s += x[k];
        const float mean = wave_sum(s) * (1.0f / 512.0f); float q = 0.f;
#pragma unroll
        for (int k = 0; k < 8; ++k) { const float d = x[k] - mean; q += d * d; }
        const float rstd = rsqrtf(wave_sum(q) * (1.0f / 512.0f) + EPS);
        if (lane == 0) { stat[row * 2] = mean; stat[row * 2 + 1] = rstd; } } }
    const float* sgw = P.in[I_SGW] + (size_t)h * 128 * 128;
#pragma unroll
    for (int it = 0; it < 8; ++it) { const int pc = tid + 512 * it, i = pc >> 5, j0 = (pc & 31) * 4; const f32x4 w4 = *(const f32x4*)(sgw + i * 128 + j0);
        const float a0 = j0 <= i ? w4.x : 0.f, a1 = j0 + 1 <= i ? w4.y : 0.f, a2 = j0 + 2 <= i ? w4.z : 0.f, a3 = j0 + 3 <= i ? w4.w : 0.f;
        *(LAS u32x2*)(wb + i * 256 + (((j0 >> 2) ^ ((i & 15) << 1)) * 8)) = (u32x2){pg8::cvt_pk_bf16(a0, a1), pg8::cvt_pk_bf16(a2, a3)}; }
    __syncthreads();
    const float* lng = P.in[I_LNG] + h * 128; const float* lnb = P.in[I_LNB] + h * 128;
#pragma unroll
    for (int it = 0; it < 4; ++it) { const int idx = tid + 512 * it, row = idx >> 4, e0 = (idx & 15) * 8;
        const u32x4 w = *(const u32x4*)(PROJ + (size_t)(R0 + row) * EIN + 1024 + h * 128 + e0); float x[8]; unpack8(w, x);
        const float mean = stat[row * 2], rstd = stat[row * 2 + 1]; float y[8];
#pragma unroll
        for (int k = 0; k < 8; ++k) y[k] = (x[k] - mean) * rstd * lng[e0 + k] + lnb[e0 + k];
        u32x4 o; o.x = pg8::cvt_pk_bf16(y[0], y[1]); o.y = pg8::cvt_pk_bf16(y[2], y[3]); o.z = pg8::cvt_pk_bf16(y[4], y[5]); o.w = pg8::cvt_pk_bf16(y[6], y[7]);
        *(LAS u32x4*)(vnb + (e0 >> 6) * 16384 + row * 128 + ((((e0 & 63) >> 3) ^ (row & 7)) * 16)) = o; }
    __syncthreads();
    const int g4 = lane >> 4, il = lane & 15;
    f32x4 acc[8];
#pragma unroll
    for (int nt = 0; nt < 8; ++nt) acc[nt] = (f32x4){0.f, 0.f, 0.f, 0.f};
    const int vr0 = 4 * g4 + (il >> 2), vx = vr0 & 7, vo = vr0 * 128 + 8 * (il & 1), vc = (il & 3) >> 1;
    const int npair = (wave + 2) >> 1;
    for (int kp = 0; kp < npair; ++kp) {
        const int ia = 16 * wave + il;
        const u32x2 a0 = *(const LAS u32x2*)(wb + ia * 256 + (((8 * kp + g4) ^ (il << 1)) * 8)), a1 = *(const LAS u32x2*)(wb + ia * 256 + (((8 * kp + 4 + g4) ^ (il << 1)) * 8));
        const bf16x8v af = __builtin_bit_cast(bf16x8v, (u32x4){a0.x, a0.y, a1.x, a1.y});
#pragma unroll
        for (int nt = 0; nt < 8; ++nt) { const LAS unsigned char* vb0 = vnb + (nt >> 2) * 16384 + (32 * kp) * 128; const int off = vo + (((2 * (nt & 3) + vc) ^ vx) * 16);
            const s16x4v va = __builtin_amdgcn_ds_read_tr16_b64_v4i16((LAS s16x4v*)(vb0 + off)), vb2 = __builtin_amdgcn_ds_read_tr16_b64_v4i16((LAS s16x4v*)(vb0 + 2048 + off));
            const bf16x8v bfg = (bf16x8v){va[0], va[1], va[2], va[3], vb2[0], vb2[1], vb2[2], vb2[3]};
            acc[nt] = __builtin_amdgcn_mfma_f32_16x16x32_bf16(af, bfg, acc[nt], 0, 0, 0); } }
    const float* sgb = P.in[I_SGB] + h * 128;
#pragma unroll
    for (int rg = 0; rg < 4; ++rg) { const int i = 16 * wave + 4 * g4 + rg; const size_t row = (size_t)(R0 + i); const float bi = sgb[i];
#pragma unroll
        for (int nt = 0; nt < 8; ++nt) { const int e = 16 * nt + il; const float uu = pg8::bf2f(PROJ[row * EIN + 512 + h * 128 + e]);
            MIX[row * 1024 + 512 + h * 128 + e] = (bf16)f2bf(uu * (acc[nt][rg] + bi)); } }
    __syncthreads();
}
__device__ __forceinline__ void sgu_sample(const Params& P, int lane, int wave) {
    const bf16* PROJ = (const bf16*)(P.ws + WS_PROJ); bf16* MIX = (bf16*)(P.ws + WS_MIX);
    for (int rr = 0; rr < 4; ++rr) { const int b = wave * 4 + rr; const size_t row = (size_t)(LP + b);
        const u32x4 w = *(const u32x4*)(PROJ + row * EIN + 1024 + lane * 8); float x[8]; unpack8(w, x);
        const u32x4 uw = *(const u32x4*)(PROJ + row * EIN + 512 + lane * 8); float uu[8]; unpack8(uw, uu);
        float s = 0.f;
#pragma unroll
        for (int k = 0; k < 8; ++k) s += x[k];
        const float mean = wave_sum(s) * (1.0f / 512.0f); float q = 0.f;
#pragma unroll
        for (int k = 0; k < 8; ++k) { const float d = x[k] - mean; q += d * d; }
        const float rstd = rsqrtf(wave_sum(q) * (1.0f / 512.0f) + EPS);
        const int col0 = lane * 8, hh = col0 >> 7; const float w00 = P.in[I_SGW][(size_t)hh * 128 * 128], b0 = P.in[I_SGB][hh * 128];
        float o[8];
#pragma unroll
        for (int k = 0; k < 8; ++k) { const float vn = (x[k] - mean) * rstd * P.in[I_LNG][col0 + k] + P.in[I_LNB][col0 + k]; P.out[O_SGUV + (size_t)b * 512 + col0 + k] = vn; o[k] = uu[k] * (w00 * vn + b0); }
        u32x4 ow; ow.x = pk2(o[0], o[1]); ow.y = pk2(o[2], o[3]); ow.z = pk2(o[4], o[5]); ow.w = pk2(o[6], o[7]);
        *(u32x4*)(MIX + row * 1024 + 512 + col0) = ow; }
}
__device__ __forceinline__ void s5_gemm1_unit(const Params& P, int g, int kt, int lane) {
    const bf16* PROJ = (const bf16*)(P.ws + WS_PROJ); const bf16* G1 = (const bf16*)(P.ws + WS_G1) + (size_t)g * 128 * 256; float* S = (float*)(P.ws + WS_SBUF) + (size_t)g * 128 * 1024;
    const int g4 = lane >> 4, kl = lane & 15, k0 = 16 * kt;
    bf16x8v bfr[8];
#pragma unroll
    for (int ks = 0; ks < 8; ++ks) bfr[ks] = *(const bf16x8v*)(PROJ + (size_t)(16 * (k0 + kl) + 2 * ks + (g4 >> 1)) * EIN + g * 16 + 8 * (g4 & 1));
    f32x4 acc[8];
#pragma unroll
    for (int mt = 0; mt < 8; ++mt) acc[mt] = (f32x4){0.f, 0.f, 0.f, 0.f};
#pragma unroll
    for (int ks = 0; ks < 8; ++ks)
#pragma unroll
        for (int mt = 0; mt < 8; ++mt) { const bf16x8v a = *(const bf16x8v*)(G1 + (size_t)(16 * mt + kl) * 256 + 32 * ks + 8 * g4); acc[mt] = __builtin_amdgcn_mfma_f32_16x16x32_bf16(a, bfr[ks], acc[mt], 0, 0, 0); }
#pragma unroll
    for (int mt = 0; mt < 8; ++mt)
#pragma unroll
        for (int rg = 0; rg < 4; ++rg) S[(size_t)(16 * mt + 4 * g4 + rg) * 1024 + k0 + kl] = acc[mt][rg];
}
__device__ __forceinline__ void s5_scan_unit(const Params& P, LAS unsigned char* lds, int g, int oct, int tid, int lane, int wave) {
    const int n = 8 * oct + wave, chn = g * 64 + n;
    const float* S = (const float*)(P.ws + WS_SBUF) + (size_t)g * 128 * 1024; const float* A2 = (const float*)(P.ws + WS_S5A);
    const float a16r = A2[4096 + 2 * chn], a16i = A2[4096 + 2 * chn + 1];
    float sr[16], si[16];
#pragma unroll
    for (int v = 0; v < 4; ++v) { const f32x4 x = *(const f32x4*)(S + (size_t)n * 1024 + 16 * lane + 4 * v), y = *(const f32x4*)(S + (size_t)(64 + n) * 1024 + 16 * lane + 4 * v);
#pragma unroll
        for (int e = 0; e < 4; ++e) { sr[4 * v + e] = x[e]; si[4 * v + e] = y[e]; } }
    float xr = 0.f, xi = 0.f;
#pragma unroll
    for (int kk = 0; kk < 16; ++kk) { const float nr = a16r * xr - a16i * xi + sr[kk], ni = a16r * xi + a16i * xr + si[kk]; xr = nr; xi = ni; }
    float mr = A2[8192 + 2 * chn], mi = A2[8192 + 2 * chn + 1];
#pragma unroll
    for (int d = 1; d < 64; d <<= 1) { const float vr = __shfl_up(xr, d), vi = __shfl_up(xi, d);
        if (lane >= d) { xr += mr * vr - mi * vi; xi += mr * vi + mi * vr; }
        const float nr = mr * mr - mi * mi, ni = 2.0f * mr * mi; mr = nr; mi = ni; }
    float hr = __shfl_up(xr, 1), hi = __shfl_up(xi, 1); if (lane == 0) { hr = 0.f; hi = 0.f; }
    LAS bf16* tile = (LAS bf16*)lds;
#pragma unroll
    for (int kk = 0; kk < 16; ++kk) { tile[(16 * lane + kk) * 16 + wave] = (bf16)f2bf(hr); tile[(16 * lane + kk) * 16 + 8 + wave] = (bf16)f2bf(hi);
        const float nr = a16r * hr - a16i * hi + sr[kk], ni = a16r * hi + a16i * hr + si[kk]; hr = nr; hi = ni; }
    if (lane == 63) { P.out[O_S5RP + chn] = hr; P.out[O_S5IP + chn] = hi; }
    __syncthreads();
    bf16* HC = (bf16*)(P.ws + WS_HCAT) + (size_t)g * 1024 * 128;
#pragma unroll
    for (int it = 0; it < 4; ++it) { const int pc = tid + 512 * it, k = pc >> 1, hf = pc & 1;
        *(u32x4*)(HC + (size_t)k * 128 + 64 * hf + 8 * oct) = *(const LAS u32x4*)(lds + k * 32 + 16 * hf); }
    __syncthreads();
}
__device__ __forceinline__ void s5_gemm3_unit(const Params& P, int g, int kt, int lane) {
    const bf16* PROJ = (const bf16*)(P.ws + WS_PROJ); bf16* Y = (bf16*)(P.ws + WS_Y);
    const bf16* KT = (const bf16*)(P.ws + WS_KTAB) + (size_t)g * 4096; const bf16* ET = (const bf16*)(P.ws + WS_ETAB) + (size_t)g * 32768; const bf16* HC = (const bf16*)(P.ws + WS_HCAT) + (size_t)g * 1024 * 128;
    const int g4 = lane >> 4, kl = lane & 15, k0 = 16 * kt;
    bf16x8v bfr[8], hfr[4];
#pragma unroll
    for (int ks = 0; ks < 8; ++ks) bfr[ks] = *(const bf16x8v*)(PROJ + (size_t)(16 * (k0 + kl) + 2 * ks + (g4 >> 1)) * EIN + g * 16 + 8 * (g4 & 1));
#pragma unroll
    for (int ks = 0; ks < 4; ++ks) hfr[ks] = *(const bf16x8v*)(HC + (size_t)(k0 + kl) * 128 + 32 * ks + 8 * g4);
    const bf16x8v zero8 = (bf16x8v){0, 0, 0, 0, 0, 0, 0, 0};
#pragma unroll
    for (int j = 0; j < 16; ++j) { f32x4 acc = (f32x4){0.f, 0.f, 0.f, 0.f};
#pragma unroll
        for (int ks = 0; ks <= (j >> 1); ++ks) { const int tau = j - 2 * ks - (g4 >> 1);
            bf16x8v a = *(const bf16x8v*)(KT + (size_t)((tau < 0 ? 0 : tau) * 16 + kl) * 16 + 8 * (g4 & 1)); if (tau < 0) a = zero8;
            acc = __builtin_amdgcn_mfma_f32_16x16x32_bf16(a, bfr[ks], acc, 0, 0, 0); }
#pragma unroll
        for (int ks = 0; ks < 4; ++ks) { const bf16x8v a = *(const bf16x8v*)(ET + (size_t)(j * 16 + kl) * 128 + 32 * ks + 8 * g4); acc = __builtin_amdgcn_mfma_f32_16x16x32_bf16(a, hfr[ks], acc, 0, 0, 0); }
        *(u32x2*)(Y + (size_t)(16 * (k0 + kl) + j) * 512 + g * 16 + 4 * g4) = (u32x2){pg8::cvt_pk_bf16(gelu_t(acc[0]), gelu_t(acc[1])), pg8::cvt_pk_bf16(gelu_t(acc[2]), gelu_t(acc[3]))}; }
}
__device__ __forceinline__ void s5_sample_unit(const Params& P, int b, int g, int lane) {
    const bf16* PROJ = (const bf16*)(P.ws + WS_PROJ); bf16* Y = (bf16*)(P.ws + WS_Y);
    const int chn = g * 64 + lane; const float* BB = (const float*)(P.ws + WS_S5BB) + (size_t)chn * 32; const float* A2 = (const float*)(P.ws + WS_S5A);
    const float ar = A2[2 * chn], ai = A2[2 * chn + 1];
    const size_t row = (size_t)(LP + b); const bf16* up = PROJ + row * EIN + g * 16;
    const u32x4 w0 = *(const u32x4*)up, w1 = *(const u32x4*)(up + 8); float u[16];
    { float a[8], bq[8]; unpack8(w0, a); unpack8(w1, bq);
#pragma unroll
      for (int k = 0; k < 8; ++k) { u[k] = a[k]; u[8 + k] = bq[k]; } }
    float br = 0.f, bi = 0.f;
#pragma unroll
    for (int p = 0; p < 16; ++p) { br += BB[p] * u[p]; bi += BB[16 + p] * u[p]; }
    const float h0r = P.in[I_S5RE][(size_t)b * 2048 + chn], h0i = P.in[I_S5IM][(size_t)b * 2048 + chn];
    const float hr = ar * h0r - ai * h0i + br, hi = ar * h0i + ai * h0r + bi;
    P.out[O_S5RS + (size_t)b * 2048 + chn] = hr; P.out[O_S5IS + (size_t)b * 2048 + chn] = hi;
    float ymine = 0.f;
#pragma unroll
    for (int p = 0; p < 16; ++p) { const float v = P.in[I_CRE][(size_t)(g * 16 + p) * 64 + lane] * hr - P.in[I_CIM][(size_t)(g * 16 + p) * 64 + lane] * hi; const float s = wave_sum(v); if (lane == p) ymine = s + P.in[I_S5D][g * 16 + p] * u[p]; }
    if (lane < 16) Y[row * 512 + g * 16 + lane] = (bf16)f2bf(gelu_t(ymine));
}

__device__ __forceinline__ void phase_conv(const Params& P, int layer, int tid) {
    const bf16* UP = (const bf16*)(P.ws + WS_UP); bf16* ACT = (bf16*)(P.ws + WS_ACT);
    const float* cw = P.in[I_CONVW] + (size_t)layer * 3 * DFF; const float* cb = P.in[I_CONVB] + (size_t)layer * DFF;
    const float* st = P.in[I_CONV] + (size_t)layer * NS * 2 * DFF;
    constexpr int NSEG = DFF / 8, RB = 8;
    const long total = (long)(LP / RB) * NSEG;
    for (long it = (long)blockIdx.x * 512 + tid; it < total; it += (long)gridDim.x * 512) {
        const int r0 = (int)(it / NSEG) * RB, c0 = (int)(it % NSEG) * 8;
        float w0[8], w1[8], w2[8], bb[8];
#pragma unroll
        for (int k = 0; k < 8; k += 4) { const f32x4 a = *(const f32x4*)(cw + c0 + k), b = *(const f32x4*)(cw + DFF + c0 + k), c = *(const f32x4*)(cw + 2 * DFF + c0 + k), d = *(const f32x4*)(cb + c0 + k);
#pragma unroll
            for (int e = 0; e < 4; ++e) { w0[k + e] = a[e]; w1[k + e] = b[e]; w2[k + e] = c[e]; bb[k + e] = d[e]; } }
        float am2[8], am1[8];
        if (r0 >= 2) { unpack8(*(const u32x4*)(UP + (size_t)(r0 - 2) * UPN + c0), am2); unpack8(*(const u32x4*)(UP + (size_t)(r0 - 1) * UPN + c0), am1); }
        else {
#pragma unroll
            for (int k = 0; k < 8; ++k) { am2[k] = 0.f; am1[k] = 0.f; } }
#pragma unroll
        for (int rr = 0; rr < RB; ++rr) { const int r = r0 + rr; float a0[8], gg[8], o[8];
            unpack8(*(const u32x4*)(UP + (size_t)r * UPN + c0), a0); unpack8(*(const u32x4*)(UP + (size_t)r * UPN + DFF + c0), gg);
#pragma unroll
            for (int k = 0; k < 8; ++k) { const float y = bb[k] + w0[k] * am2[k] + w1[k] * am1[k] + w2[k] * a0[k]; o[k] = gelu_t(y) * gg[k]; }
            u32x4 ow; ow.x = pg8::cvt_pk_bf16(o[0], o[1]); ow.y = pg8::cvt_pk_bf16(o[2], o[3]); ow.z = pg8::cvt_pk_bf16(o[4], o[5]); ow.w = pg8::cvt_pk_bf16(o[6], o[7]);
            *(u32x4*)(ACT + (size_t)r * DFF + c0) = ow;
            if (r >= LP - 2) { float* op = P.out + O_CONVP + ((size_t)layer * 2 + (r - (LP - 2))) * DFF + c0;
#pragma unroll
                for (int k = 0; k < 8; ++k) op[k] = a0[k]; }
#pragma unroll
            for (int k = 0; k < 8; ++k) { am2[k] = am1[k]; am1[k] = a0[k]; } }
    }
    for (int it = blockIdx.x * 512 + tid; it < NS * NSEG; it += gridDim.x * 512) {
        const int b = it / NSEG, c0 = (it % NSEG) * 8, r = LP + b; float a0[8], gg[8], o[8];
        unpack8(*(const u32x4*)(UP + (size_t)r * UPN + c0), a0); unpack8(*(const u32x4*)(UP + (size_t)r * UPN + DFF + c0), gg);
        float* op = P.out + O_CONVS + (((size_t)layer * NS + b) * 2) * DFF + c0;
#pragma unroll
        for (int k = 0; k < 8; ++k) { const float a2 = st[((size_t)b * 2 + 0) * DFF + c0 + k], a1 = st[((size_t)b * 2 + 1) * DFF + c0 + k];
            const float y = cb[c0 + k] + cw[c0 + k] * a2 + cw[DFF + c0 + k] * a1 + cw[2 * DFF + c0 + k] * a0[k]; o[k] = gelu_t(y) * gg[k]; op[k] = a1; op[DFF + k] = a0[k]; }
        u32x4 ow; ow.x = pg8::cvt_pk_bf16(o[0], o[1]); ow.y = pg8::cvt_pk_bf16(o[2], o[3]); ow.z = pg8::cvt_pk_bf16(o[4], o[5]); ow.w = pg8::cvt_pk_bf16(o[6], o[7]);
        *(u32x4*)(ACT + (size_t)r * DFF + c0) = ow;
    }
}

__device__ __forceinline__ void phase_rope(const Params& P, int tid) {
    bf16* QKV = (bf16*)(P.ws + WS_QKV);
    const float inv[8] = {1.0f, 0.1939227432012558f, 0.03760603070259094f, 0.007292664609849453f, 0.0014142135623842478f, 0.00027424818836152554f, 5.318296098266728e-05f, 1.0313386155758053e-05f};
    const long total = (long)MV * 16;
    for (long it = (long)blockIdx.x * 512 + tid; it < total; it += (long)gridDim.x * 512) {
        const int r = (int)(it >> 4), h = (int)(it & 15); const float pos = (float)(r < LP ? r : 16384);
        float cs[8], sn[8];
#pragma unroll
        for (int i = 0; i < 8; ++i) sincos_red(pos * inv[i], sn[i], cs[i]);
#pragma unroll
        for (int which = 0; which < 2; ++which) { bf16* p = QKV + (size_t)r * QKVN + which * 1024 + h * 64;
            float x1[8], x2[8]; unpack8(*(const u32x4*)p, x1); unpack8(*(const u32x4*)(p + 8), x2); float o1[8], o2[8];
#pragma unroll
            for (int i = 0; i < 8; ++i) { o1[i] = x1[i] * cs[i] - x2[i] * sn[i]; o2[i] = x1[i] * sn[i] + x2[i] * cs[i]; }
            u32x4 w1, w2; w1.x = pk2(o1[0], o1[1]); w1.y = pk2(o1[2], o1[3]); w1.z = pk2(o1[4], o1[5]); w1.w = pk2(o1[6], o1[7]);
            w2.x = pk2(o2[0], o2[1]); w2.y = pk2(o2[2], o2[3]); w2.z = pk2(o2[4], o2[5]); w2.w = pk2(o2[6], o2[7]);
            *(u32x4*)p = w1; *(u32x4*)(p + 8) = w2;
            if (which == 1 && (r >= LP - 2048)) {
                float* ko = r < LP ? P.out + O_KP + ((size_t)(r - (LP - 2048)) * 16 + h) * 64 : P.out + O_KS + ((size_t)(r - LP) * 16 + h) * 64;
#pragma unroll
                for (int i = 0; i < 8; ++i) { ko[i] = o1[i]; ko[8 + i] = o2[i]; }
#pragma unroll
                for (int j = 2; j < 8; ++j) { float x[8]; unpack8(*(const u32x4*)(p + 8 * j), x);
#pragma unroll
                    for (int i = 0; i < 8; ++i) ko[8 * j + i] = x[i]; } } }
        if (r >= LP - 2048) { const bf16* p = QKV + (size_t)r * QKVN + 2048 + h * 64;
            float* vo = r < LP ? P.out + O_VP + ((size_t)(r - (LP - 2048)) * 16 + h) * 64 : P.out + O_VS + ((size_t)(r - LP) * 16 + h) * 64;
#pragma unroll
            for (int j = 0; j < 8; ++j) { float x[8]; unpack8(*(const u32x4*)(p + 8 * j), x);
#pragma unroll
                for (int i = 0; i < 8; ++i) vo[8 * j + i] = x[i]; } }
    }
}

__device__ __forceinline__ void attn_stage_glds(const bf16* QKV, LAS unsigned char* buf, int h, int C0, int lane, int wave) {
#pragma unroll
    for (int t = 0; t < 4; ++t) { const int row = (4 * wave + t) * 8 + (lane >> 3), ch = (lane & 7) ^ (lane >> 3), x = 16 * (row & 15) + (row >> 4);
        const bf16* src = QKV + (size_t)(C0 + x) * QKVN + 1024 + h * 64 + ch * 8;
        __builtin_amdgcn_global_load_lds((const unsigned*)src, (LAS unsigned*)(buf + (4 * wave + t) * 1024), 16, 0, 0);
        __builtin_amdgcn_global_load_lds((const unsigned*)(src + 1024), (LAS unsigned*)(buf + 32768 + (4 * wave + t) * 1024), 16, 0, 0); }
}
__device__ __forceinline__ float xmax4(float v) {
    auto a = __builtin_amdgcn_permlane32_swap(__float_as_uint(v), __float_as_uint(v), false, false); v = fmaxf(__uint_as_float(a[0]), __uint_as_float(a[1]));
    auto b = __builtin_amdgcn_permlane16_swap(__float_as_uint(v), __float_as_uint(v), false, false); return fmaxf(__uint_as_float(b[0]), __uint_as_float(b[1]));
}
__device__ __forceinline__ float xsum4(float v) {
    auto a = __builtin_amdgcn_permlane32_swap(__float_as_uint(v), __float_as_uint(v), false, false); v = __uint_as_float(a[0]) + __uint_as_float(a[1]);
    auto b = __builtin_amdgcn_permlane16_swap(__float_as_uint(v), __float_as_uint(v), false, false); return __uint_as_float(b[0]) + __uint_as_float(b[1]);
}
__device__ __forceinline__ float lgmask(unsigned ud, unsigned A, unsigned B, unsigned C) { return ud <= A ? (ud <= B ? (ud <= C ? 1.5849625007f : 1.0f) : 0.f) : -1e30f; }

template <int NT> __device__ __forceinline__ void attn_softmax_pv(f32x4 (&s)[NT], const LAS unsigned char* const (&vb)[NT], int lane, f32x4 (&o)[4], float& m, float& l) {
    const int q = lane >> 4, i = lane & 15;
    float smax = -1e30f;
#pragma unroll
    for (int k = 0; k < NT; ++k) smax = fmaxf(fmaxf(smax, fmaxf(s[k][0], s[k][1])), fmaxf(s[k][2], s[k][3]));
    smax = xmax4(smax);
    if (__any(smax > m)) { const float mn = fmaxf(m, smax), sc = __builtin_amdgcn_exp2f(m - mn);
#pragma unroll
        for (int mt = 0; mt < 4; ++mt) o[mt] = o[mt] * sc;
        l *= sc; m = mn; }
    const int vr0 = 4 * q + (i >> 2), vx = vr0 & 7, vo = vr0 * 128 + 8 * (i & 1), vc = (i & 3) >> 1;
    float ls = 0.f;
    if constexpr (NT >= 2) {
#pragma unroll
        for (int k = 0; k < NT; k += 2) {
            float p[8];
#pragma unroll
            for (int rg = 0; rg < 4; ++rg) { p[rg] = __builtin_amdgcn_exp2f(s[k][rg] - m); p[4 + rg] = __builtin_amdgcn_exp2f(s[k + 1][rg] - m); }
            ls += ((p[0] + p[1]) + (p[2] + p[3])) + ((p[4] + p[5]) + (p[6] + p[7]));
            u32x4 pw; pw.x = pg8::cvt_pk_bf16(p[0], p[1]); pw.y = pg8::cvt_pk_bf16(p[2], p[3]); pw.z = pg8::cvt_pk_bf16(p[4], p[5]); pw.w = pg8::cvt_pk_bf16(p[6], p[7]);
            const bf16x8v pf = __builtin_bit_cast(bf16x8v, pw);
#pragma unroll
            for (int mt = 0; mt < 4; ++mt) { const int off = vo + (((2 * mt + vc) ^ vx) * 16);
                const s16x4v va = __builtin_amdgcn_ds_read_tr16_b64_v4i16((LAS s16x4v*)(vb[k] + off)), vb2 = __builtin_amdgcn_ds_read_tr16_b64_v4i16((LAS s16x4v*)(vb[k + 1] + off));
                const bf16x8v vf = (bf16x8v){va[0], va[1], va[2], va[3], vb2[0], vb2[1], vb2[2], vb2[3]};
                o[mt] = __builtin_amdgcn_mfma_f32_16x16x32_bf16(vf, pf, o[mt], 0, 0, 0); } }
    } else {
        float p[4];
#pragma unroll
        for (int rg = 0; rg < 4; ++rg) p[rg] = __builtin_amdgcn_exp2f(s[0][rg] - m);
        ls += (p[0] + p[1]) + (p[2] + p[3]);
        u32x2 pw; pw.x = pg8::cvt_pk_bf16(p[0], p[1]); pw.y = pg8::cvt_pk_bf16(p[2], p[3]);
        const s16x4v pf = __builtin_bit_cast(s16x4v, pw);
#pragma unroll
        for (int mt = 0; mt < 4; ++mt) { const int off = vo + (((2 * mt + vc) ^ vx) * 16);
            const s16x4v vf = __builtin_amdgcn_ds_read_tr16_b64_v4i16((LAS s16x4v*)(vb[0] + off));
            o[mt] = __builtin_amdgcn_mfma_f32_16x16x16bf16_1k(vf, pf, o[mt], 0, 0, 0); }
    }
    l += ls;
}
template <int NT, int CSTEP> __device__ __forceinline__ void attn_near_batch(const LAS unsigned char* buf, int cc0, int dbase, int r, int lane, const bf16x8v (&qf)[2], f32x4 (&o)[4], float& m, float& l) {
    const int q = lane >> 4, i = lane & 15;
    f32x4 s[NT]; const LAS unsigned char* vb[NT];
#pragma unroll
    for (int k = 0; k < NT; ++k) { const int cc = cc0 + k * CSTEP, krow = cc * 16 + i, kx = krow & 7; const LAS unsigned char* kb = buf + krow * 128;
        const bf16x8v k0 = *(const LAS bf16x8v*)(kb + ((q ^ kx) << 4)), k1 = *(const LAS bf16x8v*)(kb + (((q + 4) ^ kx) << 4));
        f32x4 z = (f32x4){0.f, 0.f, 0.f, 0.f};
        z = __builtin_amdgcn_mfma_f32_16x16x32_bf16(k0, qf[0], z, 0, 0, 0);
        s[k] = __builtin_amdgcn_mfma_f32_16x16x32_bf16(k1, qf[1], z, 0, 0, 0);
        vb[k] = buf + 32768 + cc * 2048; }
    const int dq = 16 * (dbase + i - 4 * q);
#pragma unroll
    for (int k = 0; k < NT; ++k) { const int cc = cc0 + k * CSTEP, e = r - cc;
        const unsigned A = e == 0 ? 2048u : ((e & 3) == 0 ? 512u : 128u), B = e == 0 ? 512u : ((e & 3) == 0 ? 128u : 0u), C = e == 0 ? 128u : 0u;
#pragma unroll
        for (int rg = 0; rg < 4; ++rg) s[k][rg] += lgmask((unsigned)(dq - 16 * rg + e), A, B, C); }
    attn_softmax_pv<NT>(s, vb, lane, o, m, l);
}
__device__ __forceinline__ void attn_far_batch(const bf16* QKV, LAS unsigned char* priv, int h, int T0, int c0, int c_first, int r, int lane, const bf16x8v (&qf)[2], f32x4 (&o)[4], float& m, float& l) {
    const int q = lane >> 4, i = lane & 15;
    bf16x8v kf[3][2]; u32x4 vp[3][2];
#pragma unroll
    for (int k = 0; k < 3; ++k) { const int c = c0 + k; const bool ex = c >= c_first; const int C0 = ex ? T0 - 2048 + 256 * c : T0;
        const bf16* kp = QKV + (size_t)(C0 + 16 * i + r) * QKVN + 1024 + h * 64 + 8 * q;
        kf[k][0] = *(const bf16x8v*)kp; kf[k][1] = *(const bf16x8v*)(kp + 32);
#pragma unroll
        for (int t = 0; t < 2; ++t) { const int pc = lane + 64 * t, jp = pc >> 3, ch = pc & 7; vp[k][t] = *(const u32x4*)(QKV + (size_t)(C0 + 16 * jp + r) * QKVN + 2048 + h * 64 + ch * 8); } }
    f32x4 s[3]; const LAS unsigned char* vb[4];
#pragma unroll
    for (int k = 0; k < 3; ++k) {
#pragma unroll
        for (int t = 0; t < 2; ++t) { const int pc = lane + 64 * t, jp = pc >> 3, ch = pc & 7; *(LAS u32x4*)(priv + k * 2048 + jp * 128 + ((ch ^ (jp & 7)) * 16)) = vp[k][t]; }
        f32x4 z = (f32x4){0.f, 0.f, 0.f, 0.f};
        z = __builtin_amdgcn_mfma_f32_16x16x32_bf16(kf[k][0], qf[0], z, 0, 0, 0);
        s[k] = __builtin_amdgcn_mfma_f32_16x16x32_bf16(kf[k][1], qf[1], z, 0, 0, 0);
        vb[k] = priv + k * 2048; }
    f32x4 s4[4];
#pragma unroll
    for (int k = 0; k < 3; ++k) { const int c = c0 + k; const unsigned A = c >= c_first ? 2048u : 0u; const int dq = 16 * (16 * (8 - c) + i - 4 * q);
#pragma unroll
        for (int rg = 0; rg < 4; ++rg) s4[k][rg] = s[k][rg] + lgmask((unsigned)(dq - 16 * rg), A, 512u, 128u); }
    s4[3] = (f32x4){-1e30f, -1e30f, -1e30f, -1e30f}; vb[3] = priv;
    attn_softmax_pv<4>(s4, vb, lane, o, m, l);
}
__device__ __forceinline__ void attn_prompt_unit(const Params& P, LAS unsigned char* lds, int h, int tb, int tid, int lane, int wave) {
    const bf16* QKV = (const bf16*)(P.ws + WS_QKV); bf16* ATT = (bf16*)(P.ws + WS_ATT);
    const int T0 = tb * 256, q = lane >> 4, i = lane & 15;
    bf16x8v qf[2][2]; f32x4 o[2][4]; float m[2], l[2];
    const float qs = 0.125f * 1.4426950408889634f;
#pragma unroll
    for (int u = 0; u < 2; ++u) { const int t = T0 + 16 * i + wave + 8 * u;
#pragma unroll
        for (int ks = 0; ks < 2; ++ks) { const u32x4 w = *(const u32x4*)(QKV + (size_t)t * QKVN + h * 64 + 32 * ks + 8 * q); float x[8]; unpack8(w, x);
            u32x4 ww; ww.x = pg8::cvt_pk_bf16(x[0] * qs, x[1] * qs); ww.y = pg8::cvt_pk_bf16(x[2] * qs, x[3] * qs); ww.z = pg8::cvt_pk_bf16(x[4] * qs, x[5] * qs); ww.w = pg8::cvt_pk_bf16(x[6] * qs, x[7] * qs);
            qf[u][ks] = __builtin_bit_cast(bf16x8v, ww); }
#pragma unroll
        for (int mt = 0; mt < 4; ++mt) o[u][mt] = (f32x4){0.f, 0.f, 0.f, 0.f};
        m[u] = -1e29f; l[u] = 0.f; }
    const int c_first = tb >= 8 ? 0 : 8 - tb;
    const int cn0 = c_first > 6 ? c_first : 6;
    attn_stage_glds(QKV, lds + ((cn0 & 1) ? 65536 : 0), h, T0 - 2048 + 256 * cn0, lane, wave);
    if (c_first < 6) {
        LAS unsigned char* priv = lds + ((cn0 & 1) ? 0 : 65536) + wave * 8192;
#pragma unroll
        for (int u = 0; u < 2; ++u) { const int r = wave + 8 * u;
            if (c_first < 3) attn_far_batch(QKV, priv, h, T0, 0, c_first, r, lane, qf[u], o[u], m[u], l[u]);
            attn_far_batch(QKV, priv, h, T0, 3, c_first, r, lane, qf[u], o[u], m[u], l[u]); }
    }
    asm volatile("s_waitcnt vmcnt(0)" ::: "memory");
    __syncthreads();
    for (int c = cn0; c <= 8; ++c) {
        const LAS unsigned char* buf = lds + ((c & 1) ? 65536 : 0);
        if (c < 8) attn_stage_glds(QKV, lds + (((c + 1) & 1) ? 65536 : 0), h, T0 - 2048 + 256 * (c + 1), lane, wave);
        const int dbase = 16 * (8 - c);
#pragma unroll
        for (int u = 0; u < 2; ++u) { const int r = wave + 8 * u;
            if (c == 6) attn_near_batch<4, 4>(buf, r & 3, dbase, r, lane, qf[u], o[u], m[u], l[u]);
            else { attn_near_batch<8, 1>(buf, 0, dbase, r, lane, qf[u], o[u], m[u], l[u]); attn_near_batch<8, 1>(buf, 8, dbase, r, lane, qf[u], o[u], m[u], l[u]); } }
        asm volatile("s_waitcnt vmcnt(0)" ::: "memory");
        __syncthreads();
    }
#pragma unroll
    for (int u = 0; u < 2; ++u) { const float il = 1.0f / xsum4(l[u]);
        const int t = T0 + 16 * i + wave + 8 * u; bf16* op = ATT + (size_t)t * 1024 + h * 64 + 4 * q;
#pragma unroll
        for (int mt = 0; mt < 4; ++mt) { const f32x4 v = o[u][mt] * il; *(u32x2*)(op + 16 * mt) = (u32x2){pg8::cvt_pk_bf16(v[0], v[1]), pg8::cvt_pk_bf16(v[2], v[3])}; } }
}
__device__ __forceinline__ const float* attn_sample_row(const float* cache, const float* newrow, int b, int h, int j) {
    const int br = j / 129, k = j - br * 129, idx = 2048 - (k << (2 * br));
    return idx == 2048 ? newrow + ((size_t)b * 16 + h) * 64 : cache + (((size_t)b * 2048 + idx) * 16 + h) * 64;
}
__device__ __forceinline__ void attn_sample_unit(const Params& P, LAS unsigned char* lds, int su, int lane, int wave) {
    const bf16* QKV = (const bf16*)(P.ws + WS_QKV); bf16* ATT = (bf16*)(P.ws + WS_ATT);
    const int unit = 2 * su + (wave >> 2), b = unit >> 4, h = unit & 15, part = wave & 3, nk = part < 3 ? 97 : 96;
    const size_t row = (size_t)(LP + b);
    LAS float* pw = (LAS float*)(lds + wave * 512);
    LAS float* pm = (LAS float*)(lds + 4096);
    LAS float* pl = pm + 8;
    LAS float* po = (LAS float*)(lds + 4608);
    float q[64];
    { const bf16* qp = QKV + row * QKVN + h * 64;
#pragma unroll
      for (int j = 0; j < 8; ++j) { float x[8]; unpack8(*(const u32x4*)(qp + 8 * j), x);
#pragma unroll
          for (int i = 0; i < 8; ++i) q[8 * j + i] = x[i] * 0.125f; } }
    const float* CK = P.in[I_CK]; const float* CV = P.in[I_CV]; const float* KN = P.out + O_KS; const float* VN = P.out + O_VS;
    float mx = -1e30f; float sv[2];
#pragma unroll
    for (int i = 0; i < 2; ++i) { const int jj = lane + 64 * i; float s = -1e30f;
        if (jj < nk) { const f32x4* kp = (const f32x4*)attn_sample_row(CK, KN, b, h, part + 4 * jj); s = 0.f;
#pragma unroll
            for (int e = 0; e < 16; ++e) { const f32x4 x = kp[e]; s += (q[4 * e] * x.x + q[4 * e + 1] * x.y) + (q[4 * e + 2] * x.z + q[4 * e + 3] * x.w); } }
        sv[i] = s; mx = fmaxf(mx, s); }
    mx = wave_max(mx); float ls = 0.f;
#pragma unroll
    for (int i = 0; i < 2; ++i) { const int jj = lane + 64 * i; const float p = (jj < nk) ? __expf(sv[i] - mx) : 0.f; ls += p; pw[jj] = p; }
    ls = wave_sum(ls);
    asm volatile("s_waitcnt lgkmcnt(0)" ::: "memory");
    float o0 = 0.f, o1 = 0.f, o2 = 0.f, o3 = 0.f;
    for (int jj = 0; jj < 96; jj += 4) {
        const float v0 = attn_sample_row(CV, VN, b, h, part + 4 * jj)[lane], v1 = attn_sample_row(CV, VN, b, h, part + 4 * (jj + 1))[lane];
        const float v2 = attn_sample_row(CV, VN, b, h, part + 4 * (jj + 2))[lane], v3 = attn_sample_row(CV, VN, b, h, part + 4 * (jj + 3))[lane];
        o0 += pw[jj] * v0; o1 += pw[jj + 1] * v1; o2 += pw[jj + 2] * v2; o3 += pw[jj + 3] * v3; }
    if (nk == 97) o0 += pw[96] * attn_sample_row(CV, VN, b, h, part + 4 * 96)[lane];
    po[wave * 64 + lane] = (o0 + o1) + (o2 + o3); if (lane == 0) { pm[wave] = mx; pl[wave] = ls; }
    __syncthreads();
    if (part == 0) { const int w0 = wave; float M = fmaxf(fmaxf(pm[w0], pm[w0 + 1]), fmaxf(pm[w0 + 2], pm[w0 + 3])); float L = 0.f, o = 0.f;
#pragma unroll
        for (int k = 0; k < 4; ++k) { const float f = __expf(pm[w0 + k] - M); L += f * pl[w0 + k]; o += f * po[(w0 + k) * 64 + lane]; }
        ATT[row * 1024 + h * 64 + lane] = (bf16)f2bf(o / L); }
    __syncthreads();
}

typedef float f32x16 __attribute__((ext_vector_type(16)));
struct SEpiStore { bf16* O; int ldc; int gelu_from;
    __device__ __forceinline__ void apply(int b, int c, float v) const { O[(size_t)(LP + b) * ldc + c] = (bf16)f2bf(c >= gelu_from ? gelu_t(v) : v); } };
struct SEpiGlu { bf16* O; int ldc; const bf16* Y; int ldy; const float* bias;
    __device__ __forceinline__ void apply(int b, int c, float v) const { const float y = pg8::bf2f(Y[(size_t)(LP + b) * ldy + c]); O[(size_t)(LP + b) * ldc + c] = (bf16)f2bf(y * pg8::sigmoidf_(v + bias[c])); } };
struct SEpiResid { float* X; const float* gate; int gstride;
    __device__ __forceinline__ void apply(int b, int c, float v) const { float* xp = X + (size_t)(LP + b) * 1024 + c; *xp = *xp + gate[(size_t)(b + 1) * gstride + c] * v; } };
template <class Epi> __device__ __forceinline__ void sample_gemm_units(LAS unsigned char* lds, const bf16* A, int lda, const bf16* Bt, int N, int K, const Epi& E, int tid, int lane, int wave, int G, int bx) {
    const int nun = N / 32, r = lane & 31, hh = lane >> 5, kw = K / 8;
    for (int su = G - 1 - bx; su < nun; su += G) {
        const int n0 = su * 32;
        f32x16 acc;
#pragma unroll
        for (int e = 0; e < 16; ++e) acc[e] = 0.f;
        const bf16* ap = A + (size_t)(LP + r) * lda + wave * kw + 8 * hh;
        const bf16* bp = Bt + (size_t)(n0 + r) * K + wave * kw + 8 * hh;
#pragma unroll 4
        for (int ks = 0; ks < kw / 16; ++ks) { const bf16x8v a = *(const bf16x8v*)(ap + 16 * ks), b = *(const bf16x8v*)(bp + 16 * ks); acc = __builtin_amdgcn_mfma_f32_32x32x16_bf16(a, b, acc, 0, 0, 0); }
        LAS float* red = (LAS float*)lds;
#pragma unroll
        for (int e = 0; e < 16; ++e) red[wave * 1056 + ((e & 3) + 8 * (e >> 2) + 4 * hh) * 33 + r] = acc[e];
        __syncthreads();
        for (int o = tid; o < 1024; o += 512) { const int row = o >> 5, col = o & 31; float v = 0.f;
#pragma unroll
            for (int w = 0; w < 8; ++w) v += red[w * 1056 + row * 33 + col];
            E.apply(row, n0 + col, v); }
        __syncthreads();
    }
}

#define XB_TMO      128
#define XB_XCNT(j)  (256  + 64 * (j))
#define XB_XSUB(j)  (1280 + 64 * (j))
#define XB_XGEN(j)  (2304 + 64 * (j))
#define XB_TOP      3328
#define XB_TOPGEN   3392
#define XCD_BAR_WORDS 3456
#define XB_SPIN_CAP (1u << 18)

__device__ __forceinline__ unsigned xb_ld(unsigned* p)              { return __hip_atomic_load(p, __ATOMIC_RELAXED, __HIP_MEMORY_SCOPE_AGENT); }
__device__ __forceinline__ unsigned xb_add(unsigned* p, unsigned v) { return __hip_atomic_fetch_add(p, v, __ATOMIC_RELAXED, __HIP_MEMORY_SCOPE_AGENT); }
__device__ __forceinline__ unsigned xb_xcc_id() { return (unsigned)__builtin_amdgcn_s_getreg((3 << 11) | 20) & 0xFu; }
#define XB_SPIN(cond, bar) do { unsigned _sp = 0; while (cond) { __builtin_amdgcn_s_sleep(1); \
    if ((++_sp & 255u) == 0u) { if (xb_ld(&(bar)[XB_TMO])) break; if (_sp > XB_SPIN_CAP) { atomicAdd(&(bar)[XB_TMO], 1u); break; } } } } while (0)

struct XcdBarrier {
    unsigned* bar; unsigned x;
    volatile LAS unsigned* st;
};

__device__ __forceinline__ XcdBarrier xcd_barrier_post(unsigned* bar, volatile LAS unsigned* st) {
    XcdBarrier b; b.bar = bar; b.x = xb_xcc_id(); b.st = st;
    if (threadIdx.x == 0) (void)xb_add(&bar[XB_XCNT(b.x)], 1u);
    return b;
}
__device__ __forceinline__ void xcd_barrier_complete(unsigned* bar, unsigned x, unsigned& nloc, unsigned& nx) {
    const unsigned G = gridDim.x * gridDim.y * gridDim.z;
    unsigned sum, cnt, mine, sp = 0u;
    for (;;) {
        sum = 0u; cnt = 0u; mine = 0u;
#pragma unroll
        for (unsigned j = 0; j < 16; ++j) { const unsigned c = xb_ld(&bar[XB_XCNT(j)]); sum += c; cnt += (c > 0u) ? 1u : 0u; mine = (j == x) ? c : mine; }
        if (sum == G) break;
        __builtin_amdgcn_s_sleep(1);
        if ((++sp & 255u) == 0u) { if (xb_ld(&bar[XB_TMO])) break; if (sp > XB_SPIN_CAP) { atomicAdd(&bar[XB_TMO], 1u); break; } }
    }
    nloc = mine > 0u ? mine : 1u; nx = cnt > 0u ? cnt : 1u;
}

__device__ __forceinline__ void xcd_barrier(const XcdBarrier& b) {
    asm volatile("s_waitcnt vmcnt(0)" ::: "memory");
    __syncthreads();
    if (threadIdx.x == 0) {
        unsigned* bar = b.bar;
        __builtin_amdgcn_s_waitcnt(0);
        unsigned nloc = b.st[0], nx = b.st[1];
        if (nloc == 0u) { xcd_barrier_complete(bar, b.x, nloc, nx); b.st[0] = nloc; b.st[1] = nx; }
        const unsigned old = xb_add(&bar[XB_XSUB(b.x)], 1u);
        const unsigned gen = old / nloc;
        if (old + 1u == (gen + 1u) * nloc) {
            __builtin_amdgcn_fence(__ATOMIC_RELEASE, "agent");
            asm volatile("s_waitcnt vmcnt(0)" ::: "memory");
            const unsigned og = xb_add(&bar[XB_TOP], 1u);
            const unsigned tg = og / nx;
            if (og + 1u == (tg + 1u) * nx) xb_add(&bar[XB_TOPGEN], 1u);
            else XB_SPIN(xb_ld(&bar[XB_TOPGEN]) == tg, bar);
            __builtin_amdgcn_fence(__ATOMIC_ACQUIRE, "agent");
            xb_add(&bar[XB_XGEN(b.x)], 1u);
            asm volatile("s_waitcnt vmcnt(0)" ::: "memory");
        } else {
            XB_SPIN(xb_ld(&bar[XB_XGEN(b.x)]) == gen, bar);
            __builtin_amdgcn_fence(__ATOMIC_ACQUIRE, "agent");
            asm volatile("s_waitcnt vmcnt(0)" ::: "memory");
        }
    }
    __syncthreads();
}

__global__ void __launch_bounds__(512, 2) mega_fwd(Params P) {
    extern __shared__ __attribute__((aligned(16))) unsigned char lds_raw[];
    LAS unsigned char* lds = (LAS unsigned char*)lds_raw;
    const int tid = threadIdx.x, lane = tid & 63, wave = __builtin_amdgcn_readfirstlane(tid >> 6);
    const int G = gridDim.x, bx = blockIdx.x;
    unsigned char* ws = P.ws;
    const int lo = P.ph_lo, hi = P.ph_hi;
    cg::grid_group grid = cg::this_grid();
    volatile LAS unsigned* bst = (volatile LAS unsigned*)(lds + LDS_BYTES - 64);
    if (tid < 16) bst[tid] = 0u;
    __syncthreads();
    XcdBarrier bar = xcd_barrier_post((unsigned*)(ws + WS_CTL) + 4096, bst);
#ifndef PHASE_MASK
#define PHASE_MASK 0xffffffffu
#endif
#define IN(k) (((PHASE_MASK >> (k)) & 1u) && lo <= (k) && (k) < hi)
#ifndef REPMASK
#define REPMASK 0u
#endif
#ifndef REPN
#define REPN 1
#endif
#define REPLOOP(k) for (int rep_ = 0, nrep_ = 1 + (((REPMASK >> (k)) & 1u) ? REPN : 0); rep_ < nrep_; (++rep_ < nrep_) ? xcd_barrier(bar) : (void)0)
#define SEAM(k) do { if (IN(k) && IN((k) + 1)) { if ((k) == 0) grid.sync(); else xcd_barrier(bar); } } while (0)
#define GEMM_PHASE(EPI, Aoff, Boff, Mm, Nn, Kk, Eobj) do { pg8::Gemm g_{(const bf16*)(ws + (Aoff)), (const bf16*)(ws + (Boff)), (Mm), (Nn), (Kk)}; pg8::StaticOrder S_; S_.init((Mm), (Nn), G, bx); \
        pg8::gemm_phase<EPI, pg8::StaticOrder, true, true>(lds, g_, S_, Eobj); } while (0)

    if (IN(0)) REPLOOP(0) { phase_prep(P, lds, tid, lane, wave); } SEAM(0);
    if (IN(1)) REPLOOP(1) { phase_norm<true>(P, 0, 0, lane, wave); } SEAM(1);
    if (IN(2)) REPLOOP(2) { pg8::EpiStore E{(bf16*)(ws + WS_PROJ), EIN, 512}; GEMM_PHASE(pg8::EpiStore, WS_H, WS_WIN, LP, EIN, 1024, E);
        SEpiStore SE{(bf16*)(ws + WS_PROJ), EIN, 512}; sample_gemm_units(lds, (const bf16*)(ws + WS_H), 1024, (const bf16*)(ws + WS_WIN), EIN, 1024, SE, tid, lane, wave, G, bx); } SEAM(2);
    if (IN(3)) REPLOOP(3) {
        const int NSGU = NCH * 4, NG1 = NG * 64 / 8, NS5S = NS * NG / 8, NU = NSGU + 1 + NG1 + NS5S;
        for (int u = bx; u < NU; u += G) {
            if (u < NSGU) sgu_unit(P, lds, u >> 2, u & 3, tid, lane, wave);
            else if (u == NSGU) sgu_sample(P, lane, wave);
            else if (u < NSGU + 1 + NG1) { const int wu = (u - NSGU - 1) * 8 + wave; s5_gemm1_unit(P, wu >> 6, wu & 63, lane); }
            else { const int wu = (u - NSGU - 1 - NG1) * 8 + wave; s5_sample_unit(P, wu >> 5, wu & 31, lane); }
        }
    } SEAM(3);
    if (IN(4)) REPLOOP(4) { for (int u = bx; u < NG * 8; u += G) s5_scan_unit(P, lds, u >> 3, u & 7, tid, lane, wave); } SEAM(4);
    if (IN(5)) REPLOOP(5) { for (int wu = bx * 8 + wave; wu < NG * 64; wu += G * 8) s5_gemm3_unit(P, wu >> 6, wu & 63, lane); } SEAM(5);
    if (IN(6)) REPLOOP(6) { pg8::EpiGlu E{(bf16*)(ws + WS_MIX), 1024, (const bf16*)(ws + WS_Y), 512, P.in[I_BGLU]}; GEMM_PHASE(pg8::EpiGlu, WS_Y, WS_WGLU, LP, 512, 512, E);
        SEpiGlu SE{(bf16*)(ws + WS_MIX), 1024, (const bf16*)(ws + WS_Y), 512, P.in[I_BGLU]}; sample_gemm_units(lds, (const bf16*)(ws + WS_Y), 512, (const bf16*)(ws + WS_WGLU), 512, 512, SE, tid, lane, wave, G, bx); } SEAM(6);
    if (IN(7)) REPLOOP(7) { pg8::EpiResid E{(float*)(ws + WS_X), (const float*)(ws + WS_MOD) + 2 * 1024, MODROW, LP, MV}; GEMM_PHASE(pg8::EpiResid, WS_MIX, WS_WOUT, LP, 1024, 1024, E);
        SEpiResid SE{(float*)(ws + WS_X), (const float*)(ws + WS_MOD) + 2 * 1024, MODROW}; sample_gemm_units(lds, (const bf16*)(ws + WS_MIX), 1024, (const bf16*)(ws + WS_WOUT), 1024, 1024, SE, tid, lane, wave, G, bx); } SEAM(7);
    if (IN(8)) REPLOOP(8) { phase_norm<false>(P, 0, 1, lane, wave); } SEAM(8);
    if (IN(9)) REPLOOP(9) { pg8::EpiStore E{(bf16*)(ws + WS_UP), UPN, 1 << 30}; GEMM_PHASE(pg8::EpiStore, WS_H, WS_WUP0, LP, UPN, 1024, E);
        SEpiStore SE{(bf16*)(ws + WS_UP), UPN, 1 << 30}; sample_gemm_units(lds, (const bf16*)(ws + WS_H), 1024, (const bf16*)(ws + WS_WUP0), UPN, 1024, SE, tid, lane, wave, G, bx); } SEAM(9);
    if (IN(10)) REPLOOP(10) { phase_conv(P, 0, tid); } SEAM(10);
    if (IN(11)) REPLOOP(11) { pg8::EpiResid E{(float*)(ws + WS_X), (const float*)(ws + WS_MOD) + 5 * 1024, MODROW, LP, MV}; GEMM_PHASE(pg8::EpiResid, WS_ACT, WS_WDN0, LP, 1024, DFF, E);
        SEpiResid SE{(float*)(ws + WS_X), (const float*)(ws + WS_MOD) + 5 * 1024, MODROW}; sample_gemm_units(lds, (const bf16*)(ws + WS_ACT), DFF, (const bf16*)(ws + WS_WDN0), 1024, DFF, SE, tid, lane, wave, G, bx); } SEAM(11);
    if (IN(12)) REPLOOP(12) { phase_norm<false>(P, 1, 0, lane, wave); } SEAM(12);
    if (IN(13)) REPLOOP(13) { pg8::EpiStore E{(bf16*)(ws + WS_QKV), QKVN, 1 << 30}; GEMM_PHASE(pg8::EpiStore, WS_H, WS_WQKV, LP, QKVN, 1024, E);
        SEpiStore SE{(bf16*)(ws + WS_QKV), QKVN, 1 << 30}; sample_gemm_units(lds, (const bf16*)(ws + WS_H), 1024, (const bf16*)(ws + WS_WQKV), QKVN, 1024, SE, tid, lane, wave, G, bx); } SEAM(13);
    if (IN(14)) REPLOOP(14) { phase_rope(P, tid); } SEAM(14);
    if (IN(15)) REPLOOP(15) {
        const int NPU = 16 * (LP / 256), NSU = NS * 16 / 2;
        for (int u = bx; u < NSU; u += G) attn_sample_unit(P, lds, u, lane, wave);
        for (int u = bx; u < NPU; u += G) { int hh, tb; if ((G & 7) == 0 && NPU % G == 0) { const int x = u & 7, li = (u % G) >> 3, rho = u / G, per = G >> 3;
                const int idx = rho * per + li; hh = 2 * x + (idx & 1); tb = idx >> 1; } else { hh = u & 15; tb = u >> 4; }
            attn_prompt_unit(P, lds, hh, tb, tid, lane, wave); }
    } SEAM(15);
    if (IN(16)) REPLOOP(16) { pg8::EpiResid E{(float*)(ws + WS_X), (const float*)(ws + WS_MOD) + MODL + 2 * 1024, MODROW, LP, MV}; GEMM_PHASE(pg8::EpiResid, WS_ATT, WS_WO, LP, 1024, 1024, E);
        SEpiResid SE{(float*)(ws + WS_X), (const float*)(ws + WS_MOD) + MODL + 2 * 1024, MODROW}; sample_gemm_units(lds, (const bf16*)(ws + WS_ATT), 1024, (const bf16*)(ws + WS_WO), 1024, 1024, SE, tid, lane, wave, G, bx); } SEAM(16);
    if (IN(17)) REPLOOP(17) { phase_norm<false>(P, 1, 1, lane, wave); } SEAM(17);
    if (IN(18)) REPLOOP(18) { pg8::EpiStore E{(bf16*)(ws + WS_UP), UPN, 1 << 30}; GEMM_PHASE(pg8::EpiStore, WS_H, WS_WUP1, LP, UPN, 1024, E);
        SEpiStore SE{(bf16*)(ws + WS_UP), UPN, 1 << 30}; sample_gemm_units(lds, (const bf16*)(ws + WS_H), 1024, (const bf16*)(ws + WS_WUP1), UPN, 1024, SE, tid, lane, wave, G, bx); } SEAM(18);
    if (IN(19)) REPLOOP(19) { phase_conv(P, 1, tid); } SEAM(19);
    if (IN(20)) REPLOOP(20) { pg8::EpiResid E{(float*)(ws + WS_X), (const float*)(ws + WS_MOD) + MODL + 5 * 1024, MODROW, LP, MV}; GEMM_PHASE(pg8::EpiResid, WS_ACT, WS_WDN1, LP, 1024, DFF, E);
        SEpiResid SE{(float*)(ws + WS_X), (const float*)(ws + WS_MOD) + MODL + 5 * 1024, MODROW}; sample_gemm_units(lds, (const bf16*)(ws + WS_ACT), DFF, (const bf16*)(ws + WS_WDN1), 1024, DFF, SE, tid, lane, wave, G, bx); } SEAM(20);
    if (IN(21)) REPLOOP(21) { phase_final_norm(P, lane, wave); }
#undef IN
#undef SEAM
#undef GEMM_PHASE
}

#ifndef N_LAUNCH_MODE
#define N_LAUNCH_MODE 1
#endif
extern "C" void kernel_launch(void* const* d_in, const int* in_sizes, int n_in, void* d_out, int out_size, void* d_ws, size_t ws_size, hipStream_t stream) {
    static int grid = 0;
    if (grid == 0) {
        if (n_in != N_IN || out_size != (int)O_TOTAL || ws_size < WS_END) { fprintf(stderr, "kernel_launch: unexpected shapes (n_in %d, out %d, ws %zu)\n", n_in, out_size, ws_size); grid = -1; return; }
        int dev = 0, cus = 0, per_cu = 0;
        if (hipGetDevice(&dev) != hipSuccess || hipDeviceGetAttribute(&cus, hipDeviceAttributeMultiprocessorCount, dev) != hipSuccess) { grid = -1; return; }
        if (hipFuncSetAttribute((const void*)mega_fwd, hipFuncAttributeMaxDynamicSharedMemorySize, LDS_BYTES) != hipSuccess) { fprintf(stderr, "kernel_launch: hipFuncSetAttribute failed\n"); grid = -1; return; }
        if (hipOccupancyMaxActiveBlocksPerMultiprocessor(&per_cu, (const void*)mega_fwd, 512, LDS_BYTES) != hipSuccess || per_cu < 1) { fprintf(stderr, "kernel_launch: occupancy query says %d\n", per_cu); per_cu = 1; }
        (void)hipGetLastError();
        grid = cus;
    }
    if (grid < 0) return;
    if (hipMemsetAsync((char*)d_ws + WS_CTL, 0, 1 * MiB, stream) != hipSuccess) { fprintf(stderr, "kernel_launch: memset failed\n"); return; }
    Params p{};
    for (int i = 0; i < N_IN; ++i) p.in[i] = (const float*)d_in[i];
    p.out = (float*)d_out; p.ws = (unsigned char*)d_ws;
#if N_LAUNCH_MODE == 1
    p.ph_lo = 0; p.ph_hi = NPHASE;
    void* args[] = {&p};
    hipError_t e = hipLaunchCooperativeKernel((const void*)mega_fwd, dim3(grid), dim3(512), args, LDS_BYTES, stream);
    if (e != hipSuccess) fprintf(stderr, "kernel_launch: cooperative launch failed: %s (grid %d)\n", hipGetErrorString(e), grid);
#else
    for (int ph = 0; ph < NPHASE; ++ph) { p.ph_lo = ph; p.ph_hi = ph + 1; hipLaunchKernelGGL(mega_fwd, dim3(grid), dim3(512), LDS_BYTES, stream, p); }
#endif
}
```

```cpp
#include <hip/hip_runtime.h>
#include <hip/hip_cooperative_groups.h>
#include <cstdio>
#include <cstdint>
namespace pg8 {
#define PG8_LAS __attribute__((address_space(3)))
typedef unsigned short bf16_t;
typedef short bf16x8 __attribute__((ext_vector_type(8)));
typedef float f32x4 __attribute__((ext_vector_type(4)));
typedef unsigned u32x4 __attribute__((ext_vector_type(4)));
constexpr int BM = 256, BK = 64, HALF = 128, HTB = HALF * BK * 2  , STAGE_BYTES = 8 * HTB, NXCD = 8, WGM = 8;

__host__ __device__ __forceinline__ int lds_byte(int r, int c) { const int st = (r >> 4) * 2 + (c >> 5), rr = r & 15, cc = c & 31, ob = rr * 64 + cc * 2; return st * 1024 + (ob ^ (((ob >> 9) & 1) << 5)); }
__host__ __device__ __forceinline__ void stage_rc(int b, int& R, int& C) { const int st = b / 1024, sb = b % 1024, swz = sb ^ (((sb >> 9) & 1) << 5); R = (st >> 1) * 16 + swz / 64; C = (st & 1) * 32 + (swz % 64) / 2; }
__host__ __device__ __forceinline__ int perm32(int rho) { const int n = rho >> 4, i = rho & 15; return 8 * (i >> 2) + 4 * n + (i & 3); }

struct Unit { int pm, pn; };
struct Gemm { const bf16_t* A; const bf16_t* Bt; int M, N, K; };

struct StaticOrder {
    int nM, nN, nwg, G, c;
    __host__ __device__ void init(int M, int N, int G_, int c_) { nM = M / BM; nN = N / BM; nwg = nM * nN; G = G_; c = c_; }
    __host__ __device__ bool next(int i, Unit& u) const {
        const long L = (long)i * G + c; if (L >= nwg) return false;
        int wgid = (int)L; { const int q = nwg / NXCD, r = nwg % NXCD, xcd = wgid % NXCD, off = wgid / NXCD; wgid = (xcd < r ? xcd * (q + 1) : r * (q + 1) + (xcd - r) * q) + off; }
        const int nig = WGM * nN, gid = wgid / nig, fm = gid * WGM, gsz = (nM - fm) < WGM ? (nM - fm) : WGM;
        u.pm = fm + ((wgid % nig) % gsz); u.pn = (wgid % nig) / gsz; return true;
    }
    __device__ __forceinline__ void a_ready(const Unit&) const {}
    __device__ __forceinline__ void done(const Unit&) const {}
};

__device__ __forceinline__ unsigned cvt_pk_bf16(float lo, float hi) { unsigned r; asm volatile("v_cvt_pk_bf16_f32 %0, %1, %2" : "=v"(r) : "v"(lo), "v"(hi)); return r; }
typedef float f32x2 __attribute__((ext_vector_type(2)));
__device__ __forceinline__ float gelu_tanh(float x) {
    const float u = x * (1.5957691216f + 0.0713548163f * x * x);
    return x / (1.0f + __expf(-u));
}
__device__ __forceinline__ float sigmoidf_(float x) { return 1.0f / (1.0f + __expf(-x)); }
__device__ __forceinline__ float bf2f(unsigned short b) { return __uint_as_float(((unsigned)b) << 16); }

struct EpiStore {
    static constexpr bool PERM = true, AFTER_DRAIN = false;
    bf16_t* O; int ldc; int gelu_from;
    __device__ __forceinline__ void operator()(const f32x4 (&acc)[2][2][4][2], const Unit& u, int wr, int wc, int fr, int fq) const {
        const int row0 = u.pm * BM + wr * 64 + fr, col0 = u.pn * BM + wc * 32 + 8 * fq;
        const bool act = (u.pn * BM) >= gelu_from;
#pragma unroll
        for (int ai = 0; ai < 2; ++ai)
#pragma unroll
            for (int m = 0; m < 4; ++m) { bf16_t* rowp = O + (size_t)(row0 + ai * HALF + m * 16) * ldc + col0;
#pragma unroll
                for (int bj = 0; bj < 2; ++bj) { f32x4 v0 = acc[ai][bj][m][0], v1 = acc[ai][bj][m][1];
                    if (act) {
#pragma unroll
                        for (int e = 0; e < 4; ++e) { v0[e] = gelu_tanh(v0[e]); v1[e] = gelu_tanh(v1[e]); } }
                    u32x4 w; w.x = cvt_pk_bf16(v0[0], v0[1]); w.y = cvt_pk_bf16(v0[2], v0[3]); w.z = cvt_pk_bf16(v1[0], v1[1]); w.w = cvt_pk_bf16(v1[2], v1[3]);
                    *(u32x4*)(rowp + bj * HALF) = w; } }
    }
};
struct EpiGlu {
    static constexpr bool PERM = true, AFTER_DRAIN = false;
    bf16_t* O; int ldc; const bf16_t* Y; int ldy; const float* bias;
    __device__ __forceinline__ void operator()(const f32x4 (&acc)[2][2][4][2], const Unit& u, int wr, int wc, int fr, int fq) const {
        const int row0 = u.pm * BM + wr * 64 + fr, col0 = u.pn * BM + wc * 32 + 8 * fq;
#pragma unroll
        for (int ai = 0; ai < 2; ++ai)
#pragma unroll
            for (int m = 0; m < 4; ++m) { const size_t r = (size_t)(row0 + ai * HALF + m * 16);
#pragma unroll
                for (int bj = 0; bj < 2; ++bj) { const int c = col0 + bj * HALF;
                    const f32x4 b0 = *(const f32x4*)(bias + c), b1 = *(const f32x4*)(bias + c + 4);
                    const u32x4 yw = *(const u32x4*)(Y + r * ldy + c);
                    f32x4 v0 = acc[ai][bj][m][0] + b0, v1 = acc[ai][bj][m][1] + b1;
                    float y[8]; y[0] = __uint_as_float(yw.x << 16); y[1] = __uint_as_float(yw.x & 0xffff0000u); y[2] = __uint_as_float(yw.y << 16); y[3] = __uint_as_float(yw.y & 0xffff0000u);
                    y[4] = __uint_as_float(yw.z << 16); y[5] = __uint_as_float(yw.z & 0xffff0000u); y[6] = __uint_as_float(yw.w << 16); y[7] = __uint_as_float(yw.w & 0xffff0000u);
#pragma unroll
                    for (int e = 0; e < 4; ++e) { v0[e] = y[e] * sigmoidf_(v0[e]); v1[e] = y[4 + e] * sigmoidf_(v1[e]); }
                    u32x4 w; w.x = cvt_pk_bf16(v0[0], v0[1]); w.y = cvt_pk_bf16(v0[2], v0[3]); w.z = cvt_pk_bf16(v1[0], v1[1]); w.w = cvt_pk_bf16(v1[2], v1[3]);
                    *(u32x4*)(O + r * ldc + c) = w; } }
    }
};
struct EpiResid {
    static constexpr bool PERM = false, AFTER_DRAIN = false;
    float* X; const float* gate; int gstride; int lp; int mvalid;
    __device__ __forceinline__ void operator()(const f32x4 (&acc)[2][2][4][2], const Unit& u, int wr, int wc, int fr, int fq) const {
        const int row0 = u.pm * BM + wr * 64 + fr, col0 = u.pn * BM + wc * 32 + 4 * fq;
#pragma unroll
        for (int ai = 0; ai < 2; ++ai)
#pragma unroll
            for (int m = 0; m < 4; ++m) { const int r = row0 + ai * HALF + m * 16;
                if (r < mvalid) { const int mrow = r < lp ? 0 : (r - lp + 1); const float* gp = gate + (size_t)mrow * gstride; float* xp = X + (size_t)r * 1024;
#pragma unroll
                    for (int bj = 0; bj < 2; ++bj)
#pragma unroll
                        for (int n = 0; n < 2; ++n) { const int c = col0 + bj * HALF + n * 16; const f32x4 g = *(const f32x4*)(gp + c); f32x4 x = *(const f32x4*)(xp + c); x = x + g * acc[ai][bj][m][n]; *(f32x4*)(xp + c) = x; } } }
    }
};
template <class Epi, class Sched, bool ALIGN_EPI = false, bool SP2 = false>
__device__ __forceinline__ void gemm_phase(PG8_LAS unsigned char* lds, const Gemm g, const Sched& S, const Epi& E) {
    const int tid = threadIdx.x, wid = __builtin_amdgcn_readfirstlane(tid >> 6), lane = tid & 63, wr = wid >> 2, wc = wid & 3, fr = lane & 15, fq = lane >> 4;
    const int K = g.K, nt = K / BK;
    unsigned voffA[2], voffB[2];
#pragma unroll
    for (int i = 0; i < 2; ++i) { int R, C; stage_rc(tid * 16 + i * 8192, R, C); const int Rb = Epi::PERM ? ((R & ~31) + perm32(R & 31)) : R;
        voffA[i] = (unsigned)(R * K + C) * 2u; voffB[i] = (unsigned)(Rb * K + C) * 2u; }
    const size_t kstep = (size_t)(BK * 2);
    const size_t hstep = (size_t)HALF * K * 2;
    const size_t tstep = 2 * hstep;
    const unsigned ldsw = (unsigned)wid * 1024u;
    const int aoff = lds_byte(wr * 64 + fr, fq * 8), boff = lds_byte(wc * 32 + fr, fq * 8);
#define PG8_SA(b, h) (((b) * 2 + (h)) * HTB)
#define PG8_SB(b, h) ((4 + (b) * 2 + (h)) * HTB)
#define PG8_STAGE(bufoff, gbase, voff) do { _Pragma("unroll") for (int _i = 0; _i < 2; ++_i) \
        __builtin_amdgcn_global_load_lds((const unsigned*)((const char*)(gbase) + (voff)[_i]), (PG8_LAS unsigned*)(lds + (bufoff) + ldsw + _i * 8192), 16, 0, 0); } while (0)
#define PG8_LDA(dst, b, h) do { _Pragma("unroll") for (int m = 0; m < 4; ++m) _Pragma("unroll") for (int k = 0; k < 2; ++k) dst[m][k] = *(const PG8_LAS bf16x8*)(lds + PG8_SA(b, h) + aoff + m * 2048 + k * 1024); } while (0)
#define PG8_LDB(dst, b, h) do { _Pragma("unroll") for (int n = 0; n < 2; ++n) _Pragma("unroll") for (int k = 0; k < 2; ++k) dst[n][k] = *(const PG8_LAS bf16x8*)(lds + PG8_SB(b, h) + boff + n * 2048 + k * 1024); } while (0)
#define PG8_MMA(ai, bj, At, Bt) do { __builtin_amdgcn_s_setprio(1); _Pragma("unroll") for (int m = 0; m < 4; ++m) _Pragma("unroll") for (int n = 0; n < 2; ++n) _Pragma("unroll") for (int k = 0; k < 2; ++k) \
        acc[ai][bj][m][n] = __builtin_amdgcn_mfma_f32_16x16x32_bf16(Bt[n][k], At[m][k], acc[ai][bj][m][n], 0, 0, 0); __builtin_amdgcn_s_setprio(0); } while (0)
#define PG8_WAIT_V(n) asm volatile("s_waitcnt vmcnt(" #n ")" ::: "memory")
#define PG8_WAIT_L(n) asm volatile("s_waitcnt lgkmcnt(" #n ")" ::: "memory")
#define PG8_BAR __builtin_amdgcn_s_barrier()
#define PG8_SCHED __builtin_amdgcn_sched_barrier(0)
    Unit cur, nxt; int ui = 0;
    if (!S.next(0, cur)) return;
    f32x4 acc[2][2][4][2];
#pragma unroll
    for (int a = 0; a < 2; ++a)
#pragma unroll
        for (int b = 0; b < 2; ++b)
#pragma unroll
            for (int m = 0; m < 4; ++m)
#pragma unroll
                for (int n = 0; n < 2; ++n) acc[a][b][m][n] = (f32x4){0.f, 0.f, 0.f, 0.f};
    bf16x8 At[4][2], B0[2][2], B1[2][2];
    const char* cA = (const char*)g.A + (size_t)cur.pm * tstep; const char* cB = (const char*)g.Bt + (size_t)cur.pn * tstep;
    S.a_ready(cur);
    if constexpr (SP2) {
        PG8_STAGE(PG8_SB(0, 0), cB, voffB); PG8_STAGE(PG8_SB(0, 1), cB + hstep, voffB); PG8_STAGE(PG8_SA(0, 0), cA, voffA); PG8_STAGE(PG8_SA(0, 1), cA + hstep, voffA);
        if (wr == 1) PG8_BAR;
        PG8_WAIT_V(2); PG8_BAR;
        PG8_STAGE(PG8_SB(1, 0), cB + kstep, voffB); PG8_STAGE(PG8_SA(1, 0), cA + kstep, voffA); PG8_STAGE(PG8_SB(1, 1), cB + hstep + kstep, voffB);
        PG8_WAIT_V(6); PG8_BAR;
    } else {
        PG8_STAGE(PG8_SB(0, 0), cB, voffB); PG8_STAGE(PG8_SA(0, 0), cA, voffA); PG8_STAGE(PG8_SB(0, 1), cB + hstep, voffB); PG8_STAGE(PG8_SA(0, 1), cA + hstep, voffA);
        if (wr == 1) PG8_BAR;
        PG8_WAIT_V(4); PG8_BAR;
        PG8_STAGE(PG8_SB(1, 0), cB + kstep, voffB); PG8_STAGE(PG8_SA(1, 0), cA + kstep, voffA); PG8_STAGE(PG8_SB(1, 1), cB + hstep + kstep, voffB);
        PG8_WAIT_V(6); PG8_BAR;
    }
    for (;;) {
        const bool has_next = S.next(ui + 1, nxt);
        const char* nA = has_next ? (const char*)g.A + (size_t)nxt.pm * tstep : cA; const char* nB = has_next ? (const char*)g.Bt + (size_t)nxt.pn * tstep : cB;
        for (int t = 0; t < nt; t += 2) {
            const bool last = (t == nt - 2);
            const char* a1 = cA + (size_t)(t + 1) * kstep;
            const char* a2 = last ? nA : cA + (size_t)(t + 2) * kstep; const char* b2 = last ? nB : cB + (size_t)(t + 2) * kstep;
            const char* a3 = a2 + kstep; const char* b3 = b2 + kstep;
            if (last && has_next) S.a_ready(nxt);
            if constexpr (SP2) {
            PG8_LDB(B0, 0, 0); PG8_LDB(B1, 0, 1); PG8_SCHED; PG8_LDA(At, 0, 0); PG8_STAGE(PG8_SA(1, 1), a1 + hstep, voffA);
            PG8_WAIT_V(8); PG8_WAIT_L(0); PG8_BAR; PG8_MMA(0, 0, At, B0); PG8_MMA(0, 1, At, B1); PG8_BAR; PG8_SCHED;
            PG8_LDA(At, 0, 1); PG8_STAGE(PG8_SB(0, 0), b2, voffB); PG8_STAGE(PG8_SB(0, 1), b2 + hstep, voffB); PG8_STAGE(PG8_SA(0, 0), a2, voffA);
            PG8_WAIT_V(8); PG8_WAIT_L(0); PG8_BAR; PG8_MMA(1, 0, At, B0); PG8_MMA(1, 1, At, B1); PG8_BAR; PG8_SCHED;
            PG8_LDB(B0, 1, 0); PG8_LDB(B1, 1, 1); PG8_SCHED; PG8_LDA(At, 1, 0); PG8_STAGE(PG8_SA(0, 1), a2 + hstep, voffA);
            PG8_WAIT_V(8); PG8_WAIT_L(0); PG8_BAR; PG8_MMA(0, 0, At, B0); PG8_MMA(0, 1, At, B1); PG8_BAR; PG8_SCHED;
            PG8_LDA(At, 1, 1); PG8_STAGE(PG8_SB(1, 0), b3, voffB); PG8_STAGE(PG8_SB(1, 1), b3 + hstep, voffB); PG8_STAGE(PG8_SA(1, 0), a3, voffA);
            PG8_WAIT_V(8); PG8_WAIT_L(0); PG8_BAR; PG8_MMA(1, 0, At, B0); PG8_MMA(1, 1, At, B1); PG8_BAR; PG8_SCHED;
            } else {
            PG8_LDB(B0, 0, 0); PG8_SCHED; PG8_LDA(At, 0, 0); PG8_STAGE(PG8_SA(1, 1), a1 + hstep, voffA);
            PG8_WAIT_L(8); PG8_BAR; PG8_WAIT_L(0); PG8_MMA(0, 0, At, B0); PG8_BAR; PG8_SCHED;
            PG8_LDB(B1, 0, 1); PG8_STAGE(PG8_SB(0, 0), b2, voffB);
            PG8_BAR; PG8_WAIT_L(0); PG8_MMA(0, 1, At, B1); PG8_BAR;
            PG8_LDA(At, 0, 1); PG8_STAGE(PG8_SA(0, 0), a2, voffA);
            PG8_BAR; PG8_WAIT_L(0); PG8_MMA(1, 0, At, B0); PG8_BAR; PG8_SCHED;
            PG8_STAGE(PG8_SB(0, 1), b2 + hstep, voffB);
            PG8_WAIT_V(6); PG8_BAR; PG8_MMA(1, 1, At, B1); PG8_BAR;
            PG8_LDB(B0, 1, 0); PG8_SCHED; PG8_LDA(At, 1, 0); PG8_STAGE(PG8_SA(0, 1), a2 + hstep, voffA);
            PG8_WAIT_L(8); PG8_BAR; PG8_WAIT_L(0); PG8_MMA(0, 0, At, B0); PG8_BAR; PG8_SCHED;
            PG8_LDB(B1, 1, 1); PG8_STAGE(PG8_SB(1, 0), b3, voffB);
            PG8_BAR; PG8_WAIT_L(0); PG8_MMA(0, 1, At, B1); PG8_BAR;
            PG8_LDA(At, 1, 1); PG8_STAGE(PG8_SA(1, 0), a3, voffA);
            PG8_BAR; PG8_WAIT_L(0); PG8_MMA(1, 0, At, B0); PG8_BAR; PG8_SCHED;
            PG8_STAGE(PG8_SB(1, 1), b3 + hstep, voffB);
            PG8_WAIT_V(6); PG8_BAR; PG8_MMA(1, 1, At, B1); PG8_BAR;
            }
        }
        if constexpr (ALIGN_EPI) { if (wr == 0) PG8_BAR; }
        if constexpr (!Epi::AFTER_DRAIN) { E(acc, cur, wr, wc, fr, fq); S.done(cur); }
        if (!has_next) break;
#pragma unroll
        for (int a = 0; a < 2; ++a)
#pragma unroll
            for (int b = 0; b < 2; ++b)
#pragma unroll
                for (int m = 0; m < 4; ++m)
#pragma unroll
                    for (int n = 0; n < 2; ++n) acc[a][b][m][n] = (f32x4){0.f, 0.f, 0.f, 0.f};
        cur = nxt; cA = nA; cB = nB; ++ui;
        if constexpr (ALIGN_EPI) { if (wr == 1) PG8_BAR; }
    }
    PG8_WAIT_V(0);
    if constexpr (!ALIGN_EPI) { if (wr == 0) PG8_BAR; }
    PG8_BAR;
    if constexpr (Epi::AFTER_DRAIN) { E.fused(acc, cur, wr, wc, fr, fq, lds, wid, lane); S.done(cur); }
#undef PG8_SA
#undef PG8_SB
#undef PG8_STAGE
#undef PG8_LDA
#undef PG8_LDB
#undef PG8_MMA
#undef PG8_WAIT_V
#undef PG8_WAIT_L
#undef PG8_BAR
#undef PG8_SCHED
}
}
namespace cg = cooperative_groups;
#define LAS __attribute__((address_space(3)))
typedef unsigned short bf16;
typedef float f32x4 __attribute__((ext_vector_type(4)));
typedef unsigned u32x4 __attribute__((ext_vector_type(4)));
typedef unsigned u32x2 __attribute__((ext_vector_type(2)));

typedef short bf16x8v __attribute__((ext_vector_type(8)));
typedef short s16x4v __attribute__((ext_vector_type(4)));

constexpr int DM = 1024, LP = 16384, NS = 32, MV = LP + NS, MT = 16640;
constexpr int EIN = 1536, DFF = 2816, UPN = 5632, QKVN = 3072;
constexpr int NG = 32, NST = 64;
constexpr int CH = 128, NCH = LP / CH;
constexpr int MODROW = 6144, MODL = 33 * MODROW;
constexpr float EPS = 1e-6f;

enum { I_XP = 0, I_XS, I_CP, I_CS, I_S5RE, I_S5IM, I_CK, I_CV, I_CONV, I_ADAW, I_ADAB, I_NORMG, I_FING, I_WIN, I_WOUT, I_LAMRE, I_LAMIM, I_LOGDT, I_BRE, I_BIM, I_CRE, I_CIM,
       I_S5D, I_WGLU, I_BGLU, I_LNG, I_LNB, I_SGW, I_SGB, I_WQKV, I_WO, I_WUP, I_CONVW, I_CONVB, I_WDN, N_IN };
constexpr size_t O_YP = 0, O_YS = 16777216, O_S5RP = 16809984, O_S5IP = 16812032, O_S5RS = 16814080, O_S5IS = 16879616, O_SGUV = 16945152, O_KP = 16961536, O_VP = 19058688,
                 O_KS = 21155840, O_VS = 21188608, O_CONVP = 21221376, O_CONVS = 21232640, O_TOTAL = 21593088;
constexpr size_t MiB = 1u << 20;
constexpr size_t WS_CTL = 0, WS_WIN = 1 * MiB, WS_WGLU = 4 * MiB, WS_WOUT = 5 * MiB, WS_WQKV = 7 * MiB, WS_WO = 13 * MiB, WS_WUP0 = 15 * MiB, WS_WUP1 = 26 * MiB, WS_WDN0 = 37 * MiB,
                 WS_WDN1 = 43 * MiB, WS_MOD = 49 * MiB, WS_S5A = 51 * MiB, WS_S5BB = 52 * MiB, WS_KTAB = 53 * MiB, WS_ETAB = 54 * MiB, WS_G1 = 56 * MiB, WS_X = 64 * MiB, WS_H = 130 * MiB, WS_PROJ = 164 * MiB,
                 WS_Y = 214 * MiB, WS_MIX = 232 * MiB, WS_UP = 266 * MiB, WS_ACT = 446 * MiB, WS_QKV = 537 * MiB, WS_ATT = 636 * MiB, WS_SBUF = 670 * MiB, WS_HCAT = 686 * MiB, WS_END = 694 * MiB;
constexpr int LDS_BYTES = 147456;
constexpr int NPHASE = 22;

struct Params { const float* in[N_IN]; float* out; unsigned char* ws; int ph_lo, ph_hi; };

__device__ __forceinline__ unsigned f2bf(float f) { unsigned u = __builtin_bit_cast(unsigned, f); return (u + 0x7fffu + ((u >> 16) & 1u)) >> 16; }
__device__ __forceinline__ unsigned pk2(float lo, float hi) { return f2bf(lo) | (f2bf(hi) << 16); }
__device__ __forceinline__ float bflo(unsigned w) { return __uint_as_float(w << 16); }
__device__ __forceinline__ float bfhi(unsigned w) { return __uint_as_float(w & 0xffff0000u); }
__device__ __forceinline__ void unpack8(const u32x4 w, float (&f)[8]) { f[0] = bflo(w.x); f[1] = bfhi(w.x); f[2] = bflo(w.y); f[3] = bfhi(w.y); f[4] = bflo(w.z); f[5] = bfhi(w.z); f[6] = bflo(w.w); f[7] = bfhi(w.w); }
__device__ __forceinline__ float wave_sum(float v) {
#pragma unroll
    for (int o = 1; o < 64; o <<= 1) v += __shfl_xor(v, o);
    return v;
}
__device__ __forceinline__ float wave_max(float v) {
#pragma unroll
    for (int o = 1; o < 64; o <<= 1) v = fmaxf(v, __shfl_xor(v, o));
    return v;
}
__device__ __forceinline__ void sincos_red(float ang, float& s, float& c) {
    const double a = (double)ang; const double n = __builtin_rint(a * 0.15915494309189535); const float r = (float)(a - n * 6.283185307179586);
    s = __sinf(r); c = __cosf(r);
}
__device__ __forceinline__ float gelu_t(float x) { return pg8::gelu_tanh(x); }

__device__ __forceinline__ void s5_disc(const Params& P, int chn, float& ar, float& ai, float& fr, float& fi) {
    const float dt = expf(P.in[I_LOGDT][chn >> 6]), lr = P.in[I_LAMRE][chn], li = P.in[I_LAMIM][chn];
    const float mag = expf(lr * dt); float sn, cs; sincos_red(li * dt, sn, cs);
    ar = mag * cs; ai = mag * sn; const float den = lr * lr + li * li;
    fr = ((ar - 1.0f) * lr + ai * li) / den; fi = (ai * lr - (ar - 1.0f) * li) / den;
}
__device__ __forceinline__ void transpose_item(const float* W, int K, int N, bf16* WT, LAS float* scr, int item, int lane) {
    const int nblk = N / 32, kb = item / nblk, nb = item % nblk, k0 = 64 * kb, n0 = 32 * nb;
    float tv[32];
#pragma unroll
    for (int i = 0; i < 32; ++i) tv[i] = W[(size_t)(k0 + 2 * i + (lane >> 5)) * N + n0 + (lane & 31)];
#pragma unroll
    for (int i = 0; i < 32; ++i) scr[(2 * i + (lane >> 5)) * 33 + (lane & 31)] = tv[i];
    asm volatile("s_waitcnt lgkmcnt(0)" ::: "memory");
    const int c = lane & 7;
#pragma unroll
    for (int j = 0; j < 4; ++j) { const int n = (lane >> 3) + 8 * j; const LAS float* s = scr + (8 * c) * 33 + n;
        u32x4 o; o.x = pk2(s[0 * 33], s[1 * 33]); o.y = pk2(s[2 * 33], s[3 * 33]); o.z = pk2(s[4 * 33], s[5 * 33]); o.w = pk2(s[6 * 33], s[7 * 33]);
        *(u32x4*)(WT + (size_t)(n0 + n) * K + k0 + 8 * c) = o; }
    asm volatile("s_waitcnt lgkmcnt(0)" ::: "memory");
}
__device__ __forceinline__ void phase_prep(const Params& P, LAS unsigned char* lds, int tid, int lane, int wave) {
    unsigned char* ws = P.ws;
    {
        LAS float* scr = (LAS float*)(lds + wave * 16384);
        const int gw = blockIdx.x * 8 + wave, NGW = gridDim.x * 8;
        constexpr int I_IN = 16 * 48, I_GLU = 8 * 16, I_OUT = 16 * 32, I_QKV = 16 * 96, I_O = 16 * 32, I_UP = 16 * 176, I_DN = 44 * 32;
        constexpr int NITEMS = I_IN + I_GLU + I_OUT + I_QKV + I_O + 2 * I_UP + 2 * I_DN;
        for (int it = gw; it < NITEMS; it += NGW) {
            int r = it;
            if (r < I_IN) { transpose_item(P.in[I_WIN], 1024, EIN, (bf16*)(ws + WS_WIN), scr, r, lane); continue; } r -= I_IN;
            if (r < I_GLU) { transpose_item(P.in[I_WGLU], 512, 512, (bf16*)(ws + WS_WGLU), scr, r, lane); continue; } r -= I_GLU;
            if (r < I_OUT) { transpose_item(P.in[I_WOUT], 1024, 1024, (bf16*)(ws + WS_WOUT), scr, r, lane); continue; } r -= I_OUT;
            if (r < I_QKV) { transpose_item(P.in[I_WQKV], 1024, QKVN, (bf16*)(ws + WS_WQKV), scr, r, lane); continue; } r -= I_QKV;
            if (r < I_O) { transpose_item(P.in[I_WO], 1024, 1024, (bf16*)(ws + WS_WO), scr, r, lane); continue; } r -= I_O;
            if (r < I_UP) { transpose_item(P.in[I_WUP], 1024, UPN, (bf16*)(ws + WS_WUP0), scr, r, lane); continue; } r -= I_UP;
            if (r < I_UP) { transpose_item(P.in[I_WUP] + (size_t)1024 * UPN, 1024, UPN, (bf16*)(ws + WS_WUP1), scr, r, lane); continue; } r -= I_UP;
            if (r < I_DN) { transpose_item(P.in[I_WDN], DFF, 1024, (bf16*)(ws + WS_WDN0), scr, r, lane); continue; } r -= I_DN;
            transpose_item(P.in[I_WDN] + (size_t)DFF * 1024, DFF, 1024, (bf16*)(ws + WS_WDN1), scr, r, lane);
        }
    }
    __syncthreads();
    for (int unit = blockIdx.x; unit < 196 + 192; unit += gridDim.x) {
        if (unit < 192) {
            const int layer = unit / 96, col0 = (unit % 96) * 64;
            LAS float* sc = (LAS float*)lds;
            for (int idx = tid; idx < 33 * 1024; idx += 512) { const int row = idx >> 10, k = idx & 1023; const float c = row == 0 ? P.in[I_CP][k] : P.in[I_CS][(row - 1) * 1024 + k]; sc[idx] = c / (1.0f + __expf(-c)); }
            __syncthreads();
            float acc[33];
#pragma unroll
            for (int r = 0; r < 33; ++r) acc[r] = 0.f;
            const float* W = P.in[I_ADAW] + (size_t)layer * 1024 * MODROW + col0 + lane;
#pragma unroll 4
            for (int k = wave * 128; k < wave * 128 + 128; k += 4) { const float w0 = W[(size_t)k * MODROW], w1 = W[(size_t)(k + 1) * MODROW], w2 = W[(size_t)(k + 2) * MODROW], w3 = W[(size_t)(k + 3) * MODROW];
#pragma unroll
                for (int r = 0; r < 33; ++r) { const f32x4 s4 = *(const LAS f32x4*)(sc + r * 1024 + k); acc[r] += (s4.x * w0 + s4.y * w1) + (s4.z * w2 + s4.w * w3); } }
            __syncthreads();
            LAS float* part = (LAS float*)lds;
#pragma unroll
            for (int r = 0; r < 33; ++r) part[(wave * 33 + r) * 64 + lane] = acc[r];
            __syncthreads();
            for (int o = tid; o < 33 * 64; o += 512) { const int r = o >> 6, l = o & 63; float s = P.in[I_ADAB][layer * MODROW + col0 + l];
#pragma unroll
                for (int w = 0; w < 8; ++w) s += part[(w * 33 + r) * 64 + l];
                ((float*)(ws + WS_MOD))[(size_t)layer * MODL + r * MODROW + col0 + l] = s; }
            __syncthreads();
        } else if (unit < 196) {
            const int chn = (unit - 192) * 512 + tid;
            float ar, ai, fr, fi; s5_disc(P, chn, ar, ai, fr, fi);
            float* A2 = (float*)(ws + WS_S5A); A2[2 * chn] = ar; A2[2 * chn + 1] = ai;
            float pr = ar, pi = ai;
#pragma unroll
            for (int i = 0; i < 4; ++i) { const float nr = pr * pr - pi * pi, ni = 2.0f * pr * pi; pr = nr; pi = ni; }
            A2[4096 + 2 * chn] = pr; A2[4096 + 2 * chn + 1] = pi;
#pragma unroll
            for (int i = 0; i < 4; ++i) { const float nr = pr * pr - pi * pi, ni = 2.0f * pr * pi; pr = nr; pi = ni; }
            A2[8192 + 2 * chn] = pr; A2[8192 + 2 * chn + 1] = pi;
            float* BB = (float*)(ws + WS_S5BB) + (size_t)chn * 32;
#pragma unroll
            for (int p = 0; p < 16; ++p) { const float br = P.in[I_BRE][chn * 16 + p], bi = P.in[I_BIM][chn * 16 + p]; BB[p] = fr * br - fi * bi; BB[16 + p] = fr * bi + fi * br; }
        } else if (unit < 196 + 64) {
            const int id = (unit - 196) * 512 + tid, nq = id & 3, q = (id >> 2) & 15, p = (id >> 6) & 15, g = id >> 10;
            LAS float* la = (LAS float*)lds;
            LAS float* lb = la + 128;
            LAS float* lc = lb + 2048;
            if (tid < 64) { float ar, ai, fr, fi; s5_disc(P, g * 64 + tid, ar, ai, fr, fi); la[2 * tid] = ar; la[2 * tid + 1] = ai; la[4224 + 2 * tid] = fr; la[4224 + 2 * tid + 1] = fi; }
            __syncthreads();
#pragma unroll
            for (int it = 0; it < 2; ++it) { const int e = tid + 512 * it, n = e >> 4; const float br = P.in[I_BRE][(size_t)g * 1024 + e], bi = P.in[I_BIM][(size_t)g * 1024 + e], fr = la[4224 + 2 * n], fi = la[4224 + 2 * n + 1];
                lb[2 * e] = fr * br - fi * bi; lb[2 * e + 1] = fr * bi + fi * br;
                lc[2 * e] = P.in[I_CRE][(size_t)g * 1024 + e]; lc[2 * e + 1] = P.in[I_CIM][(size_t)g * 1024 + e]; }
            __syncthreads();
            float acc[16];
#pragma unroll
            for (int t = 0; t < 16; ++t) acc[t] = 0.f;
            for (int nn = 0; nn < 16; ++nn) { const int n = nq * 16 + nn;
                const float ar = la[2 * n], ai = la[2 * n + 1], bbr = lb[2 * (n * 16 + q)], bbi = lb[2 * (n * 16 + q) + 1], cr = lc[2 * (p * 64 + n)], ci = lc[2 * (p * 64 + n) + 1];
                float wr = cr * bbr - ci * bbi, wi = cr * bbi + ci * bbr;
#pragma unroll
                for (int t = 0; t < 16; ++t) { acc[t] += wr; const float nr = wr * ar - wi * ai, ni = wr * ai + wi * ar; wr = nr; wi = ni; } }
#pragma unroll
            for (int t = 0; t < 16; ++t) { acc[t] += __shfl_xor(acc[t], 1); acc[t] += __shfl_xor(acc[t], 2); }
            if (nq == 0) { acc[0] += (p == q) ? P.in[I_S5D][g * 16 + p] : 0.f; bf16* KT = (bf16*)(ws + WS_KTAB);
#pragma unroll
                for (int t = 0; t < 16; ++t) KT[((size_t)(g * 16 + t) * 16 + p) * 16 + q] = (bf16)f2bf(acc[t]); }
            __syncthreads();
        } else if (unit < 196 + 128) {
            const int id = (unit - 260) * 512 + tid, n = id & 63, p = (id >> 6) & 15, g = id >> 10, chn = g * 64 + n;
            float ar, ai, fr, fi; s5_disc(P, chn, ar, ai, fr, fi);
            const float cr = P.in[I_CRE][(size_t)(g * 16 + p) * 64 + n], ci = P.in[I_CIM][(size_t)(g * 16 + p) * 64 + n];
            float wr = cr * ar - ci * ai, wi = cr * ai + ci * ar; bf16* ET = (bf16*)(ws + WS_ETAB);
#pragma unroll
            for (int j = 0; j < 16; ++j) { bf16* e = ET + ((size_t)(g * 16 + j) * 16 + p) * 128; e[n] = (bf16)f2bf(wr); e[64 + n] = (bf16)f2bf(-wi);
                const float nr = wr * ar - wi * ai, ni = wr * ai + wi * ar; wr = nr; wi = ni; }
        } else {
            const int id = (unit - 324) * 512 + tid, q = id & 15, n = (id >> 4) & 63, g = id >> 10, chn = g * 64 + n;
            float ar, ai, fr, fi; s5_disc(P, chn, ar, ai, fr, fi);
            const float br = P.in[I_BRE][chn * 16 + q], bi = P.in[I_BIM][chn * 16 + q]; float wr = fr * br - fi * bi, wi = fr * bi + fi * br;
            bf16* G1 = (bf16*)(ws + WS_G1);
#pragma unroll
            for (int t = 0; t < 16; ++t) { const int i = 15 - t; G1[((size_t)(g * 128 + n)) * 256 + i * 16 + q] = (bf16)f2bf(wr); G1[((size_t)(g * 128 + 64 + n)) * 256 + i * 16 + q] = (bf16)f2bf(wi);
                const float nr = wr * ar - wi * ai, ni = wr * ai + wi * ar; wr = nr; wi = ni; }
        }
    }
}

template <bool FIRST> __device__ __forceinline__ void phase_norm(const Params& P, int layer, int which, int lane, int wave) {
    unsigned char* ws = P.ws; float* X = (float*)(ws + WS_X); bf16* H = (bf16*)(ws + WS_H);
    const float* g = P.in[I_NORMG] + (layer * 2 + which) * 1024; const float* MOD = (const float*)(ws + WS_MOD) + (size_t)layer * MODL;
    const int shoff = which ? 3 * 1024 : 0, scoff = which ? 4 * 1024 : 1024;
    const int gw = blockIdx.x * 8 + wave, NGW = gridDim.x * 8;
    for (int r = gw; r < MT; r += NGW) {
        u32x2* ho = (u32x2*)(H + (size_t)r * 1024) + lane;
        if (r >= MV) {
#pragma unroll
            for (int j = 0; j < 4; ++j) ho[64 * j] = (u32x2){0u, 0u};
            if (FIRST) { f32x4* xo = (f32x4*)(X + (size_t)r * 1024) + lane;
#pragma unroll
                for (int j = 0; j < 4; ++j) xo[64 * j] = (f32x4){0.f, 0.f, 0.f, 0.f}; }
            continue;
        }
        const float* src = FIRST ? (r < LP ? P.in[I_XP] + (size_t)r * 1024 : P.in[I_XS] + (size_t)(r - LP) * 1024) : X + (size_t)r * 1024;
        const f32x4* xr = (const f32x4*)src + lane;
        f32x4 v[4]; float ss = 0.f;
#pragma unroll
        for (int j = 0; j < 4; ++j) { v[j] = xr[64 * j]; ss += (v[j].x * v[j].x + v[j].y * v[j].y) + (v[j].z * v[j].z + v[j].w * v[j].w); }
        const float rstd = rsqrtf(wave_sum(ss) * (1.0f / 1024.0f) + EPS);
        const float* mod = MOD + (size_t)(r < LP ? 0 : r - LP + 1) * MODROW;
#pragma unroll
        for (int j = 0; j < 4; ++j) { const int col = 4 * (lane + 64 * j);
            const f32x4 gg = *(const f32x4*)(g + col), sc = *(const f32x4*)(mod + scoff + col), sh = *(const f32x4*)(mod + shoff + col);
            const f32x4 o = v[j] * rstd * gg * (sc + 1.0f) + sh;
            ho[64 * j] = (u32x2){pk2(o.x, o.y), pk2(o.z, o.w)};
            if (FIRST) ((f32x4*)(X + (size_t)r * 1024) + lane)[64 * j] = v[j]; }
    }
}
__device__ __forceinline__ void phase_final_norm(const Params& P, int lane, int wave) {
    const float* X = (const float*)(P.ws + WS_X); const float* g = P.in[I_FING];
    const int gw = blockIdx.x * 8 + wave, NGW = gridDim.x * 8;
    for (int r = gw; r < MV; r += NGW) {
        const f32x4* xr = (const f32x4*)(X + (size_t)r * 1024) + lane;
        f32x4 v[4]; float ss = 0.f;
#pragma unroll
        for (int j = 0; j < 4; ++j) { v[j] = xr[64 * j]; ss += (v[j].x * v[j].x + v[j].y * v[j].y) + (v[j].z * v[j].z + v[j].w * v[j].w); }
        const float rstd = rsqrtf(wave_sum(ss) * (1.0f / 1024.0f) + EPS);
        float* orow = r < LP ? P.out + O_YP + (size_t)r * 1024 : P.out + O_YS + (size_t)(r - LP) * 1024;
#pragma unroll
        for (int j = 0; j < 4; ++j) { const int col = 4 * (lane + 64 * j); const f32x4 gg = *(const f32x4*)(g + col); ((f32x4*)orow + lane)[64 * j] = v[j] * rstd * gg; }
    }
}

__device__ __forceinline__ void sgu_unit(const Params& P, LAS unsigned char* lds, int c, int h, int tid, int lane, int wave) {
    const bf16* PROJ = (const bf16*)(P.ws + WS_PROJ); bf16* MIX = (bf16*)(P.ws + WS_MIX);
    LAS unsigned char* vnb = lds;
    LAS unsigned char* wb = lds + 32768;
    LAS float* stat = (LAS float*)(lds + 65536);
    const int R0 = c * CH;
    { u32x4 wv[16];
#pragma unroll
      for (int rr = 0; rr < 16; ++rr) wv[rr] = *(const u32x4*)(PROJ + (size_t)(R0 + wave * 16 + rr) * EIN + 1024 + lane * 8);
#pragma unroll
      for (int rr = 0; rr < 16; ++rr) { const int row = wave * 16 + rr; float x[8]; unpack8(wv[rr], x);
        float s = 0.f;
#pragma unroll
        for (int k = 0; k < 8; ++k) s += x[k];
        const float mean = wave_sum(s) * (1.0f / 512.0f); float q = 0.f;
#pragma unroll
        for (int k = 0; k < 8; ++k) { const float d = x[k] - mean; q += d * d; }
        const float rstd = rsqrtf(wave_sum(q) * (1.0f / 512.0f) + EPS);
        if (lane == 0) { stat[row * 2] = mean; stat[row * 2 + 1] = rstd; } } }
    const float* sgw = P.in[I_SGW] + (size_t)h * 128 * 128;
#pragma unroll
    for (int it = 0; it < 8; ++it) { const int pc = tid + 512 * it, i = pc >> 5, j0 = (pc & 31) * 4; const f32x4 w4 = *(const f32x4*)(sgw + i * 128 + j0);
        const float a0 = j0 <= i ? w4.x : 0.f, a1 = j0 + 1 <= i ? w4.y : 0.f, a2 = j0 + 2 <= i ? w4.z : 0.f, a3 = j0 + 3 <= i ? w4.w : 0.f;
        *(LAS u32x2*)(wb + i * 256 + (((j0 >> 2) ^ ((i & 15) << 1)) * 8)) = (u32x2){pg8::cvt_pk_bf16(a0, a1), pg8::cvt_pk_bf16(a2, a3)}; }
    __syncthreads();
    const float* lng = P.in[I_LNG] + h * 128; const float* lnb = P.in[I_LNB] + h * 128;
#pragma unroll
    for (int it = 0; it < 4; ++it) { const int idx = tid + 512 * it, row = idx >> 4, e0 = (idx & 15) * 8;
        const u32x4 w = *(const u32x4*)(PROJ + (size_t)(R0 + row) * EIN + 1024 + h * 128 + e0); float x[8]; unpack8(w, x);
        const float mean = stat[row * 2], rstd = stat[row * 2 + 1]; float y[8];
#pragma unroll
        for (int k = 0; k < 8; ++k) y[k] = (x[k] - mean) * rstd * lng[e0 + k] + lnb[e0 + k];
        u32x4 o; o.x = pg8::cvt_pk_bf16(y[0], y[1]); o.y = pg8::cvt_pk_bf16(y[2], y[3]); o.z = pg8::cvt_pk_bf16(y[4], y[5]); o.w = pg8::cvt_pk_bf16(y[6], y[7]);
        *(LAS u32x4*)(vnb + (e0 >> 6) * 16384 + row * 128 + ((((e0 & 63) >> 3) ^ (row & 7)) * 16)) = o; }
    __syncthreads();
    const int g4 = lane >> 4, il = lane & 15;
    f32x4 acc[8];
#pragma unroll
    for (int nt = 0; nt < 8; ++nt) acc[nt] = (f32x4){0.f, 0.f, 0.f, 0.f};
    const int vr0 = 4 * g4 + (il >> 2), vx = vr0 & 7, vo = vr0 * 128 + 8 * (il & 1), vc = (il & 3) >> 1;
    const int npair = (wave + 2) >> 1;
    for (int kp = 0; kp < npair; ++kp) {
        const int ia = 16 * wave + il;
        const u32x2 a0 = *(const LAS u32x2*)(wb + ia * 256 + (((8 * kp + g4) ^ (il << 1)) * 8)), a1 = *(const LAS u32x2*)(wb + ia * 256 + (((8 * kp + 4 + g4) ^ (il << 1)) * 8));
        const bf16x8v af = __builtin_bit_cast(bf16x8v, (u32x4){a0.x, a0.y, a1.x, a1.y});
#pragma unroll
        for (int nt = 0; nt < 8; ++nt) { const LAS unsigned char* vb0 = vnb + (nt >> 2) * 16384 + (32 * kp) * 128; const int off = vo + (((2 * (nt & 3) + vc) ^ vx) * 16);
            const s16x4v va = __builtin_amdgcn_ds_read_tr16_b64_v4i16((LAS s16x4v*)(vb0 + off)), vb2 = __builtin_amdgcn_ds_read_tr16_b64_v4i16((LAS s16x4v*)(vb0 + 2048 + off));
            const bf16x8v bfg = (bf16x8v){va[0], va[1], va[2], va[3], vb2[0], vb2[1], vb2[2], vb2[3]};
            acc[nt] = __builtin_amdgcn_mfma_f32_16x16x32_bf16(af, bfg, acc[nt], 0, 0, 0); } }
    const float* sgb = P.in[I_SGB] + h * 128;
#pragma unroll
    for (int rg = 0; rg < 4; ++rg) { const int i = 16 * wave + 4 * g4 + rg; const size_t row = (size_t)(R0 + i); const float bi = sgb[i];
#pragma unroll
        for (int nt = 0; nt < 8; ++nt) { const int e = 16 * nt + il; const float uu = pg8::bf2f(PROJ[row * EIN + 512 + h * 128 + e]);
            MIX[row * 1024 + 512 + h * 128 + e] = (bf16)f2bf(uu * (acc[nt][rg] + bi)); } }
    __syncthreads();
}
__device__ __forceinline__ void sgu_sample(const Params& P, int lane, int wave) {
    const bf16* PROJ = (const bf16*)(P.ws + WS_PROJ); bf16* MIX = (bf16*)(P.ws + WS_MIX);
    for (int rr = 0; rr < 4; ++rr) { const int b = wave * 4 + rr; const size_t row = (size_t)(LP + b);
        const u32x4 w = *(const u32x4*)(PROJ + row * EIN + 1024 + lane * 8); float x[8]; unpack8(w, x);
        const u32x4 uw = *(const u32x4*)(PROJ + row * EIN + 512 + lane * 8); float uu[8]; unpack8(uw, uu);
        float s = 0.f;
#pragma unroll
        for (int k = 0; k < 8; ++k) s += x[k];
        const float mean = wave_sum(s) * (1.0f / 512.0f); float q = 0.f;
#pragma unroll
        for (int k = 0; k < 8; ++k) { const float d = x[k] - mean; q += d * d; }
        const float rstd = rsqrtf(wave_sum(q) * (1.0f / 512.0f) + EPS);
        const int col0 = lane * 8, hh = col0 >> 7; const float w00 = P.in[I_SGW][(size_t)hh * 128 * 128], b0 = P.in[I_SGB][hh * 128];
        float o[8];
#pragma unroll
        for (int k = 0; k < 8; ++k) { const float vn = (x[k] - mean) * rstd * P.in[I_LNG][col0 + k] + P.in[I_LNB][col0 + k]; P.out[O_SGUV + (size_t)b * 512 + col0 + k] = vn; o[k] = uu[k] * (w00 * vn + b0); }
        u32x4 ow; ow.x = pk2(o[0], o[1]); ow.y = pk2(o[2], o[3]); ow.z = pk2(o[4], o[5]); ow.w = pk2(o[6], o[7]);
        *(u32x4*)(MIX + row * 1024 + 512 + col0) = ow; }
}
__device__ __forceinline__ void s5_gemm1_unit(const Params& P, int g, int kt, int lane) {
    const bf16* PROJ = (const bf16*)(P.ws + WS_PROJ); const bf16* G1 = (const bf16*)(P.ws + WS_G1) + (size_t)g * 128 * 256; float* S = (float*)(P.ws + WS_SBUF) + (size_t)g * 128 * 1024;
    const int g4 = lane >> 4, kl = lane & 15, k0 = 16 * kt;
    bf16x8v bfr[8];
#pragma unroll
    for (int ks = 0; ks < 8; ++ks) bfr[ks] = *(const bf16x8v*)(PROJ + (size_t)(16 * (k0 + kl) + 2 * ks + (g4 >> 1)) * EIN + g * 16 + 8 * (g4 & 1));
    f32x4 acc[8];
#pragma unroll
    for (int mt = 0; mt < 8; ++mt) acc[mt] = (f32x4){0.f, 0.f, 0.f, 0.f};
#pragma unroll
    for (int ks = 0; ks < 8; ++ks)
#pragma unroll
        for (int mt = 0; mt < 8; ++mt) { const bf16x8v a = *(const bf16x8v*)(G1 + (size_t)(16 * mt + kl) * 256 + 32 * ks + 8 * g4); acc[mt] = __builtin_amdgcn_mfma_f32_16x16x32_bf16(a, bfr[ks], acc[mt], 0, 0, 0); }
#pragma unroll
    for (int mt = 0; mt < 8; ++mt)
#pragma unroll
        for (int rg = 0; rg < 4; ++rg) S[(size_t)(16 * mt + 4 * g4 + rg) * 1024 + k0 + kl] = acc[mt][rg];
}
__device__ __forceinline__ void s5_scan_unit(const Params& P, LAS unsigned char* lds, int g, int oct, int tid, int lane, int wave) {
    const int n = 8 * oct + wave, chn = g * 64 + n;
    const float* S = (const float*)(P.ws + WS_SBUF) + (size_t)g * 128 * 1024; const float* A2 = (const float*)(P.ws + WS_S5A);
    const float a16r = A2[4096 + 2 * chn], a16i = A2[4096 + 2 * chn + 1];
    float sr[16], si[16];
#pragma unroll
    for (int v = 0; v < 4; ++v) { const f32x4 x = *(const f32x4*)(S + (size_t)n * 1024 + 16 * lane + 4 * v), y = *(const f32x4*)(S + (size_t)(64 + n) * 1024 + 16 * lane + 4 * v);
#pragma unroll
        for (int e = 0; e < 4; ++e) { sr[4 * v + e] = x[e]; si[4 * v + e] = y[e]; } }
    float xr = 0.f, xi = 0.f;
#pragma unroll
    for (int kk = 0; kk < 16; ++kk) { const float nr = a16r * xr - a16i * xi + sr[kk], ni = a16r * xi + a16i * xr + si[kk]; xr = nr; xi = ni; }
    float mr = A2[8192 + 2 * chn], mi = A2[8192 + 2 * chn + 1];
#pragma unroll
    for (int d = 1; d < 64; d <<= 1) { const float vr = __shfl_up(xr, d), vi = __shfl_up(xi, d);
        if (lane >= d) { xr += mr * vr - mi * vi; xi += mr * vi + mi * vr; }
        const float nr = mr * mr - mi * mi, ni = 2.0f * mr * mi; mr = nr; mi = ni; }
    float hr = __shfl_up(xr, 1), hi = __shfl_up(xi, 1); if (lane == 0) { hr = 0.f; hi = 0.f; }
    LAS bf16* tile = (LAS bf16*)lds;
#pragma unroll
    for (int kk = 0; kk < 16; ++kk) { tile[(16 * lane + kk) * 16 + wave] = (bf16)f2bf(hr); tile[(16 * lane + kk) * 16 + 8 + wave] = (bf16)f2bf(hi);
        const float nr = a16r * hr - a16i * hi + sr[kk], ni = a16r * hi + a16i * hr + si[kk]; hr = nr; hi = ni; }
    if (lane == 63) { P.out[O_S5RP + chn] = hr; P.out[O_S5IP + chn] = hi; }
    __syncthreads();
    bf16* HC = (bf16*)(P.ws + WS_HCAT) + (size_t)g * 1024 * 128;
#pragma unroll
    for (int it = 0; it < 4; ++it) { const int pc = tid + 512 * it, k = pc >> 1, hf = pc & 1;
        *(u32x4*)(HC + (size_t)k * 128 + 64 * hf + 8 * oct) = *(const LAS u32x4*)(lds + k * 32 + 16 * hf); }
    __syncthreads();
}
__device__ __forceinline__ void s5_gemm3_unit(const Params& P, int g, int kt, int lane) {
    const bf16* PROJ = (const bf16*)(P.ws + WS_PROJ); bf16* Y = (bf16*)(P.ws + WS_Y);
    const bf16* KT = (const bf16*)(P.ws + WS_KTAB) + (size_t)g * 4096; const bf16* ET = (const bf16*)(P.ws + WS_ETAB) + (size_t)g * 32768; const bf16* HC = (const bf16*)(P.ws + WS_HCAT) + (size_t)g * 1024 * 128;
    const int g4 = lane >> 4, kl = lane & 15, k0 = 16 * kt;
    bf16x8v bfr[8], hfr[4];
#pragma unroll
    for (int ks = 0; ks < 8; ++ks) bfr[ks] = *(const bf16x8v*)(PROJ + (size_t)(16 * (k0 + kl) + 2 * ks + (g4 >> 1)) * EIN + g * 16 + 8 * (g4 & 1));
#pragma unroll
    for (int ks = 0; ks < 4; ++ks) hfr[ks] = *(const bf16x8v*)(HC + (size_t)(k0 + kl) * 128 + 32 * ks + 8 * g4);
    const bf16x8v zero8 = (bf16x8v){0, 0, 0, 0, 0, 0, 0, 0};
#pragma unroll
    for (int j = 0; j < 16; ++j) { f32x4 acc = (f32x4){0.f, 0.f, 0.f, 0.f};
#pragma unroll
        for (int ks = 0; ks <= (j >> 1); ++ks) { const int tau = j - 2 * ks - (g4 >> 1);
            bf16x8v a = *(const bf16x8v*)(KT + (size_t)((tau < 0 ? 0 : tau) * 16 + kl) * 16 + 8 * (g4 & 1)); if (tau < 0) a = zero8;
            acc = __builtin_amdgcn_mfma_f32_16x16x32_bf16(a, bfr[ks], acc, 0, 0, 0); }
#pragma unroll
        for (int ks = 0; ks < 4; ++ks) { const bf16x8v a = *(const bf16x8v*)(ET + (size_t)(j * 16 + kl) * 128 + 32 * ks + 8 * g4); acc = __builtin_amdgcn_mfma_f32_16x16x32_bf16(a, hfr[ks], acc, 0, 0, 0); }
        *(u32x2*)(Y + (size_t)(16 * (k0 + kl) + j) * 512 + g * 16 + 4 * g4) = (u32x2){pg8::cvt_pk_bf16(gelu_t(acc[0]), gelu_t(acc[1])), pg8::cvt_pk_bf16(gelu_t(acc[2]), gelu_t(acc[3]))}; }
}
__device__ __forceinline__ void s5_sample_unit(const Params& P, int b, int g, int lane) {
    const bf16* PROJ = (const bf16*)(P.ws + WS_PROJ); bf16* Y = (bf16*)(P.ws + WS_Y);
    const int chn = g * 64 + lane; const float* BB = (const float*)(P.ws + WS_S5BB) + (size_t)chn * 32; const float* A2 = (const float*)(P.ws + WS_S5A);
    const float ar = A2[2 * chn], ai = A2[2 * chn + 1];
    const size_t row = (size_t)(LP + b); const bf16* up = PROJ + row * EIN + g * 16;
    const u32x4 w0 = *(const u32x4*)up, w1 = *(const u32x4*)(up + 8); float u[16];
    { float a[8], bq[8]; unpack8(w0, a); unpack8(w1, bq);
#pragma unroll
      for (int k = 0; k < 8; ++k) { u[k] = a[k]; u[8 + k] = bq[k]; } }
    float br = 0.f, bi = 0.f;
#pragma unroll
    for (int p = 0; p < 16; ++p) { br += BB[p] * u[p]; bi += BB[16 + p] * u[p]; }
    const float h0r = P.in[I_S5RE][(size_t)b * 2048 + chn], h0i = P.in[I_S5IM][(size_t)b * 2048 + chn];
    const float hr = ar * h0r - ai * h0i + br, hi = ar * h0i + ai * h0r + bi;
    P.out[O_S5RS + (size_t)b * 2048 + chn] = hr; P.out[O_S5IS + (size_t)b * 2048 + chn] = hi;
    float ymine = 0.f;
#pragma unroll
    for (int p = 0; p < 16; ++p) { const float v = P.in[I_CRE][(size_t)(g * 16 + p) * 64 + lane] * hr - P.in[I_CIM][(size_t)(g * 16 + p) * 64 + lane] * hi; const float s = wave_sum(v); if (lane == p) ymine = s + P.in[I_S5D][g * 16 + p] * u[p]; }
    if (lane < 16) Y[row * 512 + g * 16 + lane] = (bf16)f2bf(gelu_t(ymine));
}

__device__ __forceinline__ void phase_conv(const Params& P, int layer, int tid) {
    const bf16* UP = (const bf16*)(P.ws + WS_UP); bf16* ACT = (bf16*)(P.ws + WS_ACT);
    const float* cw = P.in[I_CONVW] + (size_t)layer * 3 * DFF; const float* cb = P.in[I_CONVB] + (size_t)layer * DFF;
    const float* st = P.in[I_CONV] + (size_t)layer * NS * 2 * DFF;
    constexpr int NSEG = DFF / 8, RB = 8;
    const long total = (long)(LP / RB) * NSEG;
    for (long it = (long)blockIdx.x * 512 + tid; it < total; it += (long)gridDim.x * 512) {
        const int r0 = (int)(it / NSEG) * RB, c0 = (int)(it % NSEG) * 8;
        float w0[8], w1[8], w2[8], bb[8];
#pragma unroll
        for (int k = 0; k < 8; k += 4) { const f32x4 a = *(const f32x4*)(cw + c0 + k), b = *(const f32x4*)(cw + DFF + c0 + k), c = *(const f32x4*)(cw + 2 * DFF + c0 + k), d = *(const f32x4*)(cb + c0 + k);
#pragma unroll
            for (int e = 0; e < 4; ++e) { w0[k + e] = a[e]; w1[k + e] = b[e]; w2[k + e] = c[e]; bb[k + e] = d[e]; } }
        float am2[8], am1[8];
        if (r0 >= 2) { unpack8(*(const u32x4*)(UP + (size_t)(r0 - 2) * UPN + c0), am2); unpack8(*(const u32x4*)(UP + (size_t)(r0 - 1) * UPN + c0), am1); }
        else {
#pragma unroll
            for (int k = 0; k < 8; ++k) { am2[k] = 0.f; am1[k] = 0.f; } }
#pragma unroll
        for (int rr = 0; rr < RB; ++rr) { const int r = r0 + rr; float a0[8], gg[8], o[8];
            unpack8(*(const u32x4*)(UP + (size_t)r * UPN + c0), a0); unpack8(*(const u32x4*)(UP + (size_t)r * UPN + DFF + c0), gg);
#pragma unroll
            for (int k = 0; k < 8; ++k) { const float y = bb[k] + w0[k] * am2[k] + w1[k] * am1[k] + w2[k] * a0[k]; o[k] = gelu_t(y) * gg[k]; }
            u32x4 ow; ow.x = pg8::cvt_pk_bf16(o[0], o[1]); ow.y = pg8::cvt_pk_bf16(o[2], o[3]); ow.z = pg8::cvt_pk_bf16(o[4], o[5]); ow.w = pg8::cvt_pk_bf16(o[6], o[7]);
            *(u32x4*)(ACT + (size_t)r * DFF + c0) = ow;
            if (r >= LP - 2) { float* op = P.out + O_CONVP + ((size_t)layer * 2 + (r - (LP - 2))) * DFF + c0;
#pragma unroll
                for (int k = 0; k < 8; ++k) op[k] = a0[k]; }
#pragma unroll
            for (int k = 0; k < 8; ++k) { am2[k] = am1[k]; am1[k] = a0[k]; } }
    }
    for (int it = blockIdx.x * 512 + tid; it < NS * NSEG; it += gridDim.x * 512) {
        const int b = it / NSEG, c0 = (it % NSEG) * 8, r = LP + b; float a0[8], gg[8], o[8];
        unpack8(*(const u32x4*)(UP + (size_t)r * UPN + c0), a0); unpack8(*(const u32x4*)(UP + (size_t)r * UPN + DFF + c0), gg);
        float* op = P.out + O_CONVS + (((size_t)layer * NS + b) * 2) * DFF + c0;
#pragma unroll
        for (int k = 0; k < 8; ++k) { const float a2 = st[((size_t)b * 2 + 0) * DFF + c0 + k], a1 = st[((size_t)b * 2 + 1) * DFF + c0 + k];
            const float y = cb[c0 + k] + cw[c0 + k] * a2 + cw[DFF + c0 + k] * a1 + cw[2 * DFF + c0 + k] * a0[k]; o[k] = gelu_t(y) * gg[k]; op[k] = a1; op[DFF + k] = a0[k]; }
        u32x4 ow; ow.x = pg8::cvt_pk_bf16(o[0], o[1]); ow.y = pg8::cvt_pk_bf16(o[2], o[3]); ow.z = pg8::cvt_pk_bf16(o[4], o[5]); ow.w = pg8::cvt_pk_bf16(o[6], o[7]);
        *(u32x4*)(ACT + (size_t)r * DFF + c0) = ow;
    }
}

__device__ __forceinline__ void phase_rope(const Params& P, int tid) {
    bf16* QKV = (bf16*)(P.ws + WS_QKV);
    const float inv[8] = {1.0f, 0.1939227432012558f, 0.03760603070259094f, 0.007292664609849453f, 0.0014142135623842478f, 0.00027424818836152554f, 5.318296098266728e-05f, 1.0313386155758053e-05f};
    const long total = (long)MV * 16;
    for (long it = (long)blockIdx.x * 512 + tid; it < total; it += (long)gridDim.x * 512) {
        const int r = (int)(it >> 4), h = (int)(it & 15); const float pos = (float)(r < LP ? r : 16384);
        float cs[8], sn[8];
#pragma unroll
        for (int i = 0; i < 8; ++i) sincos_red(pos * inv[i], sn[i], cs[i]);
#pragma unroll
        for (int which = 0; which < 2; ++which) { bf16* p = QKV + (size_t)r * QKVN + which * 1024 + h * 64;
            float x1[8], x2[8]; unpack8(*(const u32x4*)p, x1); unpack8(*(const u32x4*)(p + 8), x2); float o1[8], o2[8];
#pragma unroll
            for (int i = 0; i < 8; ++i) { o1[i] = x1[i] * cs[i] - x2[i] * sn[i]; o2[i] = x1[i] * sn[i] + x2[i] * cs[i]; }
            u32x4 w1, w2; w1.x = pk2(o1[0], o1[1]); w1.y = pk2(o1[2], o1[3]); w1.z = pk2(o1[4], o1[5]); w1.w = pk2(o1[6], o1[7]);
            w2.x = pk2(o2[0], o2[1]); w2.y = pk2(o2[2], o2[3]); w2.z = pk2(o2[4], o2[5]); w2.w = pk2(o2[6], o2[7]);
            *(u32x4*)p = w1; *(u32x4*)(p + 8) = w2;
            if (which == 1 && (r >= LP - 2048)) {
                float* ko = r < LP ? P.out + O_KP + ((size_t)(r - (LP - 2048)) * 16 + h) * 64 : P.out + O_KS + ((size_t)(r - LP) * 16 + h) * 64;
#pragma unroll
                for (int i = 0; i < 8; ++i) { ko[i] = o1[i]; ko[8 + i] = o2[i]; }
#pragma unroll
                for (int j = 2; j < 8; ++j) { float x[8]; unpack8(*(const u32x4*)(p + 8 * j), x);
#pragma unroll
                    for (int i = 0; i < 8; ++i) ko[8 * j + i] = x[i]; } } }
        if (r >= LP - 2048) { const bf16* p = QKV + (size_t)r * QKVN + 2048 + h * 64;
            float* vo = r < LP ? P.out + O_VP + ((size_t)(r - (LP - 2048)) * 16 + h) * 64 : P.out + O_VS + ((size_t)(r - LP) * 16 + h) * 64;
#pragma unroll
            for (int j = 0; j < 8; ++j) { float x[8]; unpack8(*(const u32x4*)(p + 8 * j), x);
#pragma unroll
                for (int i = 0; i < 8; ++i) vo[8 * j + i] = x[i]; } }
    }
}

__device__ __forceinline__ void attn_stage_glds(const bf16* QKV, LAS unsigned char* buf, int h, int C0, int lane, int wave) {
#pragma unroll
    for (int t = 0; t < 4; ++t) { const int row = (4 * wave + t) * 8 + (lane >> 3), ch = (lane & 7) ^ (lane >> 3), x = 16 * (row & 15) + (row >> 4);
        const bf16* src = QKV + (size_t)(C0 + x) * QKVN + 1024 + h * 64 + ch * 8;
        __builtin_amdgcn_global_load_lds((const unsigned*)src, (LAS unsigned*)(buf + (4 * wave + t) * 1024), 16, 0, 0);
        __builtin_amdgcn_global_load_lds((const unsigned*)(src + 1024), (LAS unsigned*)(buf + 32768 + (4 * wave + t) * 1024), 16, 0, 0); }
}
__device__ __forceinline__ float xmax4(float v) {
    auto a = __builtin_amdgcn_permlane32_swap(__float_as_uint(v), __float_as_uint(v), false, false); v = fmaxf(__uint_as_float(a[0]), __uint_as_float(a[1]));
    auto b = __builtin_amdgcn_permlane16_swap(__float_as_uint(v), __float_as_uint(v), false, false); return fmaxf(__uint_as_float(b[0]), __uint_as_float(b[1]));
}
__device__ __forceinline__ float xsum4(float v) {
    auto a = __builtin_amdgcn_permlane32_swap(__float_as_uint(v), __float_as_uint(v), false, false); v = __uint_as_float(a[0]) + __uint_as_float(a[1]);
    auto b = __builtin_amdgcn_permlane16_swap(__float_as_uint(v), __float_as_uint(v), false, false); return __uint_as_float(b[0]) + __uint_as_float(b[1]);
}
__device__ __forceinline__ float lgmask(unsigned ud, unsigned A, unsigned B, unsigned C) { return ud <= A ? (ud <= B ? (ud <= C ? 1.5849625007f : 1.0f) : 0.f) : -1e30f; }

template <int NT> __device__ __forceinline__ void attn_softmax_pv(f32x4 (&s)[NT], const LAS unsigned char* const (&vb)[NT], int lane, f32x4 (&o)[4], float& m, float& l) {
    const int q = lane >> 4, i = lane & 15;
    float smax = -1e30f;
#pragma unroll
    for (int k = 0; k < NT; ++k) smax = fmaxf(fmaxf(smax, fmaxf(s[k][0], s[k][1])), fmaxf(s[k][2], s[k][3]));
    smax = xmax4(smax);
    if (__any(smax > m)) { const float mn = fmaxf(m, smax), sc = __builtin_amdgcn_exp2f(m - mn);
#pragma unroll
        for (int mt = 0; mt < 4; ++mt) o[mt] = o[mt] * sc;
        l *= sc; m = mn; }
    const int vr0 = 4 * q + (i >> 2), vx = vr0 & 7, vo = vr0 * 128 + 8 * (i & 1), vc = (i & 3) >> 1;
    float ls = 0.f;
    if constexpr (NT >= 2) {
#pragma unroll
        for (int k = 0; k < NT; k += 2) {
            float p[8];
#pragma unroll
            for (int rg = 0; rg < 4; ++rg) { p[rg] = __builtin_amdgcn_exp2f(s[k][rg] - m); p[4 + rg] = __builtin_amdgcn_exp2f(s[k + 1][rg] - m); }
            ls += ((p[0] + p[1]) + (p[2] + p[3])) + ((p[4] + p[5]) + (p[6] + p[7]));
            u32x4 pw; pw.x = pg8::cvt_pk_bf16(p[0], p[1]); pw.y = pg8::cvt_pk_bf16(p[2], p[3]); pw.z = pg8::cvt_pk_bf16(p[4], p[5]); pw.w = pg8::cvt_pk_bf16(p[6], p[7]);
            const bf16x8v pf = __builtin_bit_cast(bf16x8v, pw);
#pragma unroll
            for (int mt = 0; mt < 4; ++mt) { const int off = vo + (((2 * mt + vc) ^ vx) * 16);
                const s16x4v va = __builtin_amdgcn_ds_read_tr16_b64_v4i16((LAS s16x4v*)(vb[k] + off)), vb2 = __builtin_amdgcn_ds_read_tr16_b64_v4i16((LAS s16x4v*)(vb[k + 1] + off));
                const bf16x8v vf = (bf16x8v){va[0], va[1], va[2], va[3], vb2[0], vb2[1], vb2[2], vb2[3]};
                o[mt] = __builtin_amdgcn_mfma_f32_16x16x32_bf16(vf, pf, o[mt], 0, 0, 0); } }
    } else {
        float p[4];
#pragma unroll
        for (int rg = 0; rg < 4; ++rg) p[rg] = __builtin_amdgcn_exp2f(s[0][rg] - m);
        ls += (p[0] + p[1]) + (p[2] + p[3]);
        u32x2 pw; pw.x = pg8::cvt_pk_bf16(p[0], p[1]); pw.y = pg8::cvt_pk_bf16(p[2], p[3]);
        const s16x4v pf = __builtin_bit_cast(s16x4v, pw);
#pragma unroll
        for (int mt = 0; mt < 4; ++mt) { const int off = vo + (((2 * mt + vc) ^ vx) * 16);
            const s16x4v vf = __builtin_amdgcn_ds_read_tr16_b64_v4i16((LAS s16x4v*)(vb[0] + off));
            o[mt] = __builtin_amdgcn_mfma_f32_16x16x16bf16_1k(vf, pf, o[mt], 0, 0, 0); }
    }
    l += ls;
}
template <int NT, int CSTEP> __device__ __forceinline__ void attn_near_batch(const LAS unsigned char* buf, int cc0, int dbase, int r, int lane, const bf16x8v (&qf)[2], f32x4 (&o)[4], float& m, float& l) {
    const int q = lane >> 4, i = lane & 15;
    f32x4 s[NT]; const LAS unsigned char* vb[NT];
#pragma unroll
    for (int k = 0; k < NT; ++k) { const int cc = cc0 + k * CSTEP, krow = cc * 16 + i, kx = krow & 7; const LAS unsigned char* kb = buf + krow * 128;
        const bf16x8v k0 = *(const LAS bf16x8v*)(kb + ((q ^ kx) << 4)), k1 = *(const LAS bf16x8v*)(kb + (((q + 4) ^ kx) << 4));
        f32x4 z = (f32x4){0.f, 0.f, 0.f, 0.f};
        z = __builtin_amdgcn_mfma_f32_16x16x32_bf16(k0, qf[0], z, 0, 0, 0);
        s[k] = __builtin_amdgcn_mfma_f32_16x16x32_bf16(k1, qf[1], z, 0, 0, 0);
        vb[k] = buf + 32768 + cc * 2048; }
    const int dq = 16 * (dbase + i - 4 * q);
#pragma unroll
    for (int k = 0; k < NT; ++k) { const int cc = cc0 + k * CSTEP, e = r - cc;
        const unsigned A = e == 0 ? 2048u : ((e & 3) == 0 ? 512u : 128u), B = e == 0 ? 512u : ((e & 3) == 0 ? 128u : 0u), C = e == 0 ? 128u : 0u;
#pragma unroll
        for (int rg = 0; rg < 4; ++rg) s[k][rg] += lgmask((unsigned)(dq - 16 * rg + e), A, B, C); }
    attn_softmax_pv<NT>(s, vb, lane, o, m, l);
}
__device__ __forceinline__ void attn_far_batch(const bf16* QKV, LAS unsigned char* priv, int h, int T0, int c0, int c_first, int r, int lane, const bf16x8v (&qf)[2], f32x4 (&o)[4], float& m, float& l) {
    const int q = lane >> 4, i = lane & 15;
    bf16x8v kf[3][2]; u32x4 vp[3][2];
#pragma unroll
    for (int k = 0; k < 3; ++k) { const int c = c0 + k; const bool ex = c >= c_first; const int C0 = ex ? T0 - 2048 + 256 * c : T0;
        const bf16* kp = QKV + (size_t)(C0 + 16 * i + r) * QKVN + 1024 + h * 64 + 8 * q;
        kf[k][0] = *(const bf16x8v*)kp; kf[k][1] = *(const bf16x8v*)(kp + 32);
#pragma unroll
        for (int t = 0; t < 2; ++t) { const int pc = lane + 64 * t, jp = pc >> 3, ch = pc & 7; vp[k][t] = *(const u32x4*)(QKV + (size_t)(C0 + 16 * jp + r) * QKVN + 2048 + h * 64 + ch * 8); } }
    f32x4 s[3]; const LAS unsigned char* vb[4];
#pragma unroll
    for (int k = 0; k < 3; ++k) {
#pragma unroll
        for (int t = 0; t < 2; ++t) { const int pc = lane + 64 * t, jp = pc >> 3, ch = pc & 7; *(LAS u32x4*)(priv + k * 2048 + jp * 128 + ((ch ^ (jp & 7)) * 16)) = vp[k][t]; }
        f32x4 z = (f32x4){0.f, 0.f, 0.f, 0.f};
        z = __builtin_amdgcn_mfma_f32_16x16x32_bf16(kf[k][0], qf[0], z, 0, 0, 0);
        s[k] = __builtin_amdgcn_mfma_f32_16x16x32_bf16(kf[k][1], qf[1], z, 0, 0, 0);
        vb[k] = priv + k * 2048; }
    f32x4 s4[4];
#pragma unroll
    for (int k = 0; k < 3; ++k) { const int c = c0 + k; const unsigned A = c >= c_first ? 2048u : 0u; const int dq = 16 * (16 * (8 - c) + i - 4 * q);
#pragma unroll
        for (int rg = 0; rg < 4; ++rg) s4[k][rg] = s[k][rg] + lgmask((unsigned)(dq - 16 * rg), A, 512u, 128u); }
    s4[3] = (f32x4){-1e30f, -1e30f, -1e30f, -1e30f}; vb[3] = priv;
    attn_softmax_pv<4>(s4, vb, lane, o, m, l);
}
__device__ __forceinline__ void attn_prompt_unit(const Params& P, LAS unsigned char* lds, int h, int tb, int tid, int lane, int wave) {
    const bf16* QKV = (const bf16*)(P.ws + WS_QKV); bf16* ATT = (bf16*)(P.ws + WS_ATT);
    const int T0 = tb * 256, q = lane >> 4, i = lane & 15;
    bf16x8v qf[2][2]; f32x4 o[2][4]; float m[2], l[2];
    const float qs = 0.125f * 1.4426950408889634f;
#pragma unroll
    for (int u = 0; u < 2; ++u) { const int t = T0 + 16 * i + wave + 8 * u;
#pragma unroll
        for (int ks = 0; ks < 2; ++ks) { const u32x4 w = *(const u32x4*)(QKV + (size_t)t * QKVN + h * 64 + 32 * ks + 8 * q); float x[8]; unpack8(w, x);
            u32x4 ww; ww.x = pg8::cvt_pk_bf16(x[0] * qs, x[1] * qs); ww.y = pg8::cvt_pk_bf16(x[2] * qs, x[3] * qs); ww.z = pg8::cvt_pk_bf16(x[4] * qs, x[5] * qs); ww.w = pg8::cvt_pk_bf16(x[6] * qs, x[7] * qs);
            qf[u][ks] = __builtin_bit_cast(bf16x8v, ww); }
#pragma unroll
        for (int mt = 0; mt < 4; ++mt) o[u][mt] = (f32x4){0.f, 0.f, 0.f, 0.f};
        m[u] = -1e29f; l[u] = 0.f; }
    const int c_first = tb >= 8 ? 0 : 8 - tb;
    const int cn0 = c_first > 6 ? c_first : 6;
    attn_stage_glds(QKV, lds + ((cn0 & 1) ? 65536 : 0), h, T0 - 2048 + 256 * cn0, lane, wave);
    if (c_first < 6) {
        LAS unsigned char* priv = lds + ((cn0 & 1) ? 0 : 65536) + wave * 8192;
#pragma unroll
        for (int u = 0; u < 2; ++u) { const int r = wave + 8 * u;
            if (c_first < 3) attn_far_batch(QKV, priv, h, T0, 0, c_first, r, lane, qf[u], o[u], m[u], l[u]);
            attn_far_batch(QKV, priv, h, T0, 3, c_first, r, lane, qf[u], o[u], m[u], l[u]); }
    }
    asm volatile("s_waitcnt vmcnt(0)" ::: "memory");
    __syncthreads();
    for (int c = cn0; c <= 8; ++c) {
        const LAS unsigned char* buf = lds + ((c & 1) ? 65536 : 0);
        if (c < 8) attn_stage_glds(QKV, lds + (((c + 1) & 1) ? 65536 : 0), h, T0 - 2048 + 256 * (c + 1), lane, wave);
        const int dbase = 16 * (8 - c);
#pragma unroll
        for (int u = 0; u < 2; ++u) { const int r = wave + 8 * u;
            if (c == 6) attn_near_batch<4, 4>(buf, r & 3, dbase, r, lane, qf[u], o[u], m[u], l[u]);
            else { attn_near_batch<8, 1>(buf, 0, dbase, r, lane, qf[u], o[u], m[u], l[u]); attn_near_batch<8, 1>(buf, 8, dbase, r, lane, qf[u], o[u], m[u], l[u]); } }
        asm volatile("s_waitcnt vmcnt(0)" ::: "memory");
        __syncthreads();
    }
#pragma unroll
    for (int u = 0; u < 2; ++u) { const float il = 1.0f / xsum4(l[u]);
        const int t = T0 + 16 * i + wave + 8 * u; bf16* op = ATT + (size_t)t * 1024 + h * 64 + 4 * q;
#pragma unroll
        for (int mt = 0; mt < 4; ++mt) { const f32x4 v = o[u][mt] * il; *(u32x2*)(op + 16 * mt) = (u32x2){pg8::cvt_pk_bf16(v[0], v[1]), pg8::cvt_pk_bf16(v[2], v[3])}; } }
}
__device__ __forceinline__ const float* attn_sample_row(const float* cache, const float* newrow, int b, int h, int j) {
    const int br = j / 129, k = j - br * 129, idx = 2048 - (k << (2 * br));
    return idx == 2048 ? newrow + ((size_t)b * 16 + h) * 64 : cache + (((size_t)b * 2048 + idx) * 16 + h) * 64;
}
__device__ __forceinline__ void attn_sample_unit(const Params& P, LAS unsigned char* lds, int su, int lane, int wave) {
    const bf16* QKV = (const bf16*)(P.ws + WS_QKV); bf16* ATT = (bf16*)(P.ws + WS_ATT);
    const int unit = 2 * su + (wave >> 2), b = unit >> 4, h = unit & 15, part = wave & 3, nk = part < 3 ? 97 : 96;
    const size_t row = (size_t)(LP + b);
    LAS float* pw = (LAS float*)(lds + wave * 512);
    LAS float* pm = (LAS float*)(lds + 4096);
    LAS float* pl = pm + 8;
    LAS float* po = (LAS float*)(lds + 4608);
    float q[64];
    { const bf16* qp = QKV + row * QKVN + h * 64;
#pragma unroll
      for (int j = 0; j < 8; ++j) { float x[8]; unpack8(*(const u32x4*)(qp + 8 * j), x);
#pragma unroll
          for (int i = 0; i < 8; ++i) q[8 * j + i] = x[i] * 0.125f; } }
    const float* CK = P.in[I_CK]; const float* CV = P.in[I_CV]; const float* KN = P.out + O_KS; const float* VN = P.out + O_VS;
    float mx = -1e30f; float sv[2];
#pragma unroll
    for (int i = 0; i < 2; ++i) { const int jj = lane + 64 * i; float s = -1e30f;
        if (jj < nk) { const f32x4* kp = (const f32x4*)attn_sample_row(CK, KN, b, h, part + 4 * jj); s = 0.f;
#pragma unroll
            for (int e = 0; e < 16; ++e) { const f32x4 x = kp[e]; s += (q[4 * e] * x.x + q[4 * e + 1] * x.y) + (q[4 * e + 2] * x.z + q[4 * e + 3] * x.w); } }
        sv[i] = s; mx = fmaxf(mx, s); }
    mx = wave_max(mx); float ls = 0.f;
#pragma unroll
    for (int i = 0; i < 2; ++i) { const int jj = lane + 64 * i; const float p = (jj < nk) ? __expf(sv[i] - mx) : 0.f; ls += p; pw[jj] = p; }
    ls = wave_sum(ls);
    asm volatile("s_waitcnt lgkmcnt(0)" ::: "memory");
    float o0 = 0.f, o1 = 0.f, o2 = 0.f, o3 = 0.f;
    for (int jj = 0; jj < 96; jj += 4) {
        const float v0 = attn_sample_row(CV, VN, b, h, part + 4 * jj)[lane], v1 = attn_sample_row(CV, VN, b, h, part + 4 * (jj + 1))[lane];
        const float v2 = attn_sample_row(CV, VN, b, h, part + 4 * (jj + 2))[lane], v3 = attn_sample_row(CV, VN, b, h, part + 4 * (jj + 3))[lane];
        o0 += pw[jj] * v0; o1 += pw[jj + 1] * v1; o2 += pw[jj + 2] * v2; o3 += pw[jj + 3] * v3; }
    if (nk == 97) o0 += pw[96] * attn_sample_row(CV, VN, b, h, part + 4 * 96)[lane];
    po[wave * 64 + lane] = (o0 + o1) + (o2 + o3); if (lane == 0) { pm[wave] = mx; pl[wave] = ls; }
    __syncthreads();
    if (part == 0) { const int w0 = wave; float M = fmaxf(fmaxf(pm[w0], pm[w0 + 1]), fmaxf(pm[w0 + 2], pm[w0 + 3])); float L = 0.f, o = 0.f;
#pragma unroll
        for (int k = 0; k < 4; ++k) { const float f = __expf(pm[w0 + k] - M); L += f * pl[w0 + k]; o += f * po[(w0 + k) * 64 + lane]; }
        ATT[row * 1024 + h * 64 + lane] = (bf16)f2bf(o / L); }
    __syncthreads();
}

typedef float f32x16 __attribute__((ext_vector_type(16)));
struct SEpiStore { bf16* O; int ldc; int gelu_from;
    __device__ __forceinline__ void apply(int b, int c, float v) const { O[(size_t)(LP + b) * ldc + c] = (bf16)f2bf(c >= gelu_from ? gelu_t(v) : v); } };
struct SEpiGlu { bf16* O; int ldc; const bf16* Y; int ldy; const float* bias;
    __device__ __forceinline__ void apply(int b, int c, float v) const { const float y = pg8::bf2f(Y[(size_t)(LP + b) * ldy + c]); O[(size_t)(LP + b) * ldc + c] = (bf16)f2bf(y * pg8::sigmoidf_(v + bias[c])); } };
struct SEpiResid { float* X; const float* gate; int gstride;
    __device__ __forceinline__ void apply(int b, int c, float v) const { float* xp = X + (size_t)(LP + b) * 1024 + c; *xp = *xp + gate[(size_t)(b + 1) * gstride + c] * v; } };
template <class Epi> __device__ __forceinline__ void sample_gemm_units(LAS unsigned char* lds, const bf16* A, int lda, const bf16* Bt, int N, int K, const Epi& E, int tid, int lane, int wave, int G, int bx) {
    const int nun = N / 32, r = lane & 31, hh = lane >> 5, kw = K / 8;
    for (int su = G - 1 - bx; su < nun; su += G) {
        const int n0 = su * 32;
        f32x16 acc;
#pragma unroll
        for (int e = 0; e < 16; ++e) acc[e] = 0.f;
        const bf16* ap = A + (size_t)(LP + r) * lda + wave * kw + 8 * hh;
        const bf16* bp = Bt + (size_t)(n0 + r) * K + wave * kw + 8 * hh;
#pragma unroll 4
        for (int ks = 0; ks < kw / 16; ++ks) { const bf16x8v a = *(const bf16x8v*)(ap + 16 * ks), b = *(const bf16x8v*)(bp + 16 * ks); acc = __builtin_amdgcn_mfma_f32_32x32x16_bf16(a, b, acc, 0, 0, 0); }
        LAS float* red = (LAS float*)lds;
#pragma unroll
        for (int e = 0; e < 16; ++e) red[wave * 1056 + ((e & 3) + 8 * (e >> 2) + 4 * hh) * 33 + r] = acc[e];
        __syncthreads();
        for (int o = tid; o < 1024; o += 512) { const int row = o >> 5, col = o & 31; float v = 0.f;
#pragma unroll
            for (int w = 0; w < 8; ++w) v += red[w * 1056 + row * 33 + col];
            E.apply(row, n0 + col, v); }
        __syncthreads();
    }
}

#define XB_TMO      128
#define XB_XCNT(j)  (256  + 64 * (j))
#define XB_XSUB(j)  (1280 + 64 * (j))
#define XB_XGEN(j)  (2304 + 64 * (j))
#define XB_TOP      3328
#define XB_TOPGEN   3392
#define XCD_BAR_WORDS 3456
#define XB_SPIN_CAP (1u << 18)

__device__ __forceinline__ unsigned xb_ld(unsigned* p)              { return __hip_atomic_load(p, __ATOMIC_RELAXED, __HIP_MEMORY_SCOPE_AGENT); }
__device__ __forceinline__ unsigned xb_add(unsigned* p, unsigned v) { return __hip_atomic_fetch_add(p, v, __ATOMIC_RELAXED, __HIP_MEMORY_SCOPE_AGENT); }
__device__ __forceinline__ unsigned xb_xcc_id() { return (unsigned)__builtin_amdgcn_s_getreg((3 << 11) | 20) & 0xFu; }
#define XB_SPIN(cond, bar) do { unsigned _sp = 0; while (cond) { __builtin_amdgcn_s_sleep(1); \
    if ((++_sp & 255u) == 0u) { if (xb_ld(&(bar)[XB_TMO])) break; if (_sp > XB_SPIN_CAP) { atomicAdd(&(bar)[XB_TMO], 1u); break; } } } } while (0)

struct XcdBarrier {
    unsigned* bar; unsigned x;
    volatile LAS unsigned* st;
};

__device__ __forceinline__ XcdBarrier xcd_barrier_post(unsigned* bar, volatile LAS unsigned* st) {
    XcdBarrier b; b.bar = bar; b.x = xb_xcc_id(); b.st = st;
    if (threadIdx.x == 0) (void)xb_add(&bar[XB_XCNT(b.x)], 1u);
    return b;
}
__device__ __forceinline__ void xcd_barrier_complete(unsigned* bar, unsigned x, unsigned& nloc, unsigned& nx) {
    const unsigned G = gridDim.x * gridDim.y * gridDim.z;
    unsigned sum, cnt, mine, sp = 0u;
    for (;;) {
        sum = 0u; cnt = 0u; mine = 0u;
#pragma unroll
        for (unsigned j = 0; j < 16; ++j) { const unsigned c = xb_ld(&bar[XB_XCNT(j)]); sum += c; cnt += (c > 0u) ? 1u : 0u; mine = (j == x) ? c : mine; }
        if (sum == G) break;
        __builtin_amdgcn_s_sleep(1);
        if ((++sp & 255u) == 0u) { if (xb_ld(&bar[XB_TMO])) break; if (sp > XB_SPIN_CAP) { atomicAdd(&bar[XB_TMO], 1u); break; } }
    }
    nloc = mine > 0u ? mine : 1u; nx = cnt > 0u ? cnt : 1u;
}

__device__ __forceinline__ void xcd_barrier(const XcdBarrier& b) {
    asm volatile("s_waitcnt vmcnt(0)" ::: "memory");
    __syncthreads();
    if (threadIdx.x == 0) {
        unsigned* bar = b.bar;
        __builtin_amdgcn_s_waitcnt(0);
        unsigned nloc = b.st[0], nx = b.st[1];
        if (nloc == 0u) { xcd_barrier_complete(bar, b.x, nloc, nx); b.st[0] = nloc; b.st[1] = nx; }
        const unsigned old = xb_add(&bar[XB_XSUB(b.x)], 1u);
        const unsigned gen = old / nloc;
        if (old + 1u == (gen + 1u) * nloc) {
            __builtin_amdgcn_fence(__ATOMIC_RELEASE, "agent");
            asm volatile("s_waitcnt vmcnt(0)" ::: "memory");
            const unsigned og = xb_add(&bar[XB_TOP], 1u);
            const unsigned tg = og / nx;
            if (og + 1u == (tg + 1u) * nx) xb_add(&bar[XB_TOPGEN], 1u);
            else XB_SPIN(xb_ld(&bar[XB_TOPGEN]) == tg, bar);
            __builtin_amdgcn_fence(__ATOMIC_ACQUIRE, "agent");
            xb_add(&bar[XB_XGEN(b.x)], 1u);
            asm volatile("s_waitcnt vmcnt(0)" ::: "memory");
        } else {
            XB_SPIN(xb_ld(&bar[XB_XGEN(b.x)]) == gen, bar);
            __builtin_amdgcn_fence(__ATOMIC_ACQUIRE, "agent");
            asm volatile("s_waitcnt vmcnt(0)" ::: "memory");
        }
    }
    __syncthreads();
}

__global__ void __launch_bounds__(512, 2) mega_fwd(Params P) {
    extern __shared__ __attribute__((aligned(16))) unsigned char lds_raw[];
    LAS unsigned char* lds = (LAS unsigned char*)lds_raw;
    const int tid = threadIdx.x, lane = tid & 63, wave = __builtin_amdgcn_readfirstlane(tid >> 6);
    const int G = gridDim.x, bx = blockIdx.x;
    unsigned char* ws = P.ws;
    const int lo = P.ph_lo, hi = P.ph_hi;
    cg::grid_group grid = cg::this_grid();
    volatile LAS unsigned* bst = (volatile LAS unsigned*)(lds + LDS_BYTES - 64);
    if (tid < 16) bst[tid] = 0u;
    __syncthreads();
    XcdBarrier bar = xcd_barrier_post((unsigned*)(ws + WS_CTL) + 4096, bst);
#ifndef PHASE_MASK
#define PHASE_MASK 0xffffffffu
#endif
#define IN(k) (((PHASE_MASK >> (k)) & 1u) && lo <= (k) && (k) < hi)
#ifndef REPMASK
#define REPMASK 0u
#endif
#ifndef REPN
#define REPN 1
#endif
#define REPLOOP(k) for (int rep_ = 0, nrep_ = 1 + (((REPMASK >> (k)) & 1u) ? REPN : 0); rep_ < nrep_; (++rep_ < nrep_) ? xcd_barrier(bar) : (void)0)
#define SEAM(k) do { if (IN(k) && IN((k) + 1)) { if ((k) == 0) grid.sync(); else xcd_barrier(bar); } } while (0)
#define GEMM_PHASE(EPI, Aoff, Boff, Mm, Nn, Kk, Eobj) do { pg8::Gemm g_{(const bf16*)(ws + (Aoff)), (const bf16*)(ws + (Boff)), (Mm), (Nn), (Kk)}; pg8::StaticOrder S_; S_.init((Mm), (Nn), G, bx); \
        pg8::gemm_phase<EPI, pg8::StaticOrder, true, true>(lds, g_, S_, Eobj); } while (0)

    if (IN(0)) REPLOOP(0) { phase_prep(P, lds, tid, lane, wave); } SEAM(0);
    if (IN(1)) REPLOOP(1) { phase_norm<true>(P, 0, 0, lane, wave); } SEAM(1);
    if (IN(2)) REPLOOP(2) { pg8::EpiStore E{(bf16*)(ws + WS_PROJ), EIN, 512}; GEMM_PHASE(pg8::EpiStore, WS_H, WS_WIN, LP, EIN, 1024, E);
        SEpiStore SE{(bf16*)(ws + WS_PROJ), EIN, 512}; sample_gemm_units(lds, (const bf16*)(ws + WS_H), 1024, (const bf16*)(ws + WS_WIN), EIN, 1024, SE, tid, lane, wave, G, bx); } SEAM(2);
    if (IN(3)) REPLOOP(3) {
        const int NSGU = NCH * 4, NG1 = NG * 64 / 8, NS5S = NS * NG / 8, NU = NSGU + 1 + NG1 + NS5S;
        for (int u = bx; u < NU; u += G) {
            if (u < NSGU) sgu_unit(P, lds, u >> 2, u & 3, tid, lane, wave);
            else if (u == NSGU) sgu_sample(P, lane, wave);
            else if (u < NSGU + 1 + NG1) { const int wu = (u - NSGU - 1) * 8 + wave; s5_gemm1_unit(P, wu >> 6, wu & 63, lane); }
            else { const int wu = (u - NSGU - 1 - NG1) * 8 + wave; s5_sample_unit(P, wu >> 5, wu & 31, lane); }
        }
    } SEAM(3);
    if (IN(4)) REPLOOP(4) { for (int u = bx; u < NG * 8; u += G) s5_scan_unit(P, lds, u >> 3, u & 7, tid, lane, wave); } SEAM(4);
    if (IN(5)) REPLOOP(5) { for (int wu = bx * 8 + wave; wu < NG * 64; wu += G * 8) s5_gemm3_unit(P, wu >> 6, wu & 63, lane); } SEAM(5);
    if (IN(6)) REPLOOP(6) { pg8::EpiGlu E{(bf16*)(ws + WS_MIX), 1024, (const bf16*)(ws + WS_Y), 512, P.in[I_BGLU]}; GEMM_PHASE(pg8::EpiGlu, WS_Y, WS_WGLU, LP, 512, 512, E);
        SEpiGlu SE{(bf16*)(ws + WS_MIX), 1024, (const bf16*)(ws + WS_Y), 512, P.in[I_BGLU]}; sample_gemm_units(lds, (const bf16*)(ws + WS_Y), 512, (const bf16*)(ws + WS_WGLU), 512, 512, SE, tid, lane, wave, G, bx); } SEAM(6);
    if (IN(7)) REPLOOP(7) { pg8::EpiResid E{(float*)(ws + WS_X), (const float*)(ws + WS_MOD) + 2 * 1024, MODROW, LP, MV}; GEMM_PHASE(pg8::EpiResid, WS_MIX, WS_WOUT, LP, 1024, 1024, E);
        SEpiResid SE{(float*)(ws + WS_X), (const float*)(ws + WS_MOD) + 2 * 1024, MODROW}; sample_gemm_units(lds, (const bf16*)(ws + WS_MIX), 1024, (const bf16*)(ws + WS_WOUT), 1024, 1024, SE, tid, lane, wave, G, bx); } SEAM(7);
    if (IN(8)) REPLOOP(8) { phase_norm<false>(P, 0, 1, lane, wave); } SEAM(8);
    if (IN(9)) REPLOOP(9) { pg8::EpiStore E{(bf16*)(ws + WS_UP), UPN, 1 << 30}; GEMM_PHASE(pg8::EpiStore, WS_H, WS_WUP0, LP, UPN, 1024, E);
        SEpiStore SE{(bf16*)(ws + WS_UP), UPN, 1 << 30}; sample_gemm_units(lds, (const bf16*)(ws + WS_H), 1024, (const bf16*)(ws + WS_WUP0), UPN, 1024, SE, tid, lane, wave, G, bx); } SEAM(9);
    if (IN(10)) REPLOOP(10) { phase_conv(P, 0, tid); } SEAM(10);
    if (IN(11)) REPLOOP(11) { pg8::EpiResid E{(float*)(ws + WS_X), (const float*)(ws + WS_MOD) + 5 * 1024, MODROW, LP, MV}; GEMM_PHASE(pg8::EpiResid, WS_ACT, WS_WDN0, LP, 1024, DFF, E);
        SEpiResid SE{(float*)(ws + WS_X), (const float*)(ws + WS_MOD) + 5 * 1024, MODROW}; sample_gemm_units(lds, (const bf16*)(ws + WS_ACT), DFF, (const bf16*)(ws + WS_WDN0), 1024, DFF, SE, tid, lane, wave, G, bx); } SEAM(11);
    if (IN(12)) REPLOOP(12) { phase_norm<false>(P, 1, 0, lane, wave); } SEAM(12);
    if (IN(13)) REPLOOP(13) { pg8::EpiStore E{(bf16*)(ws + WS_QKV), QKVN, 1 << 30}; GEMM_PHASE(pg8::EpiStore, WS_H, WS_WQKV, LP, QKVN, 1024, E);
        SEpiStore SE{(bf16*)(ws + WS_QKV), QKVN, 1 << 30}; sample_gemm_units(lds, (const bf16*)(ws + WS_H), 1024, (const bf16*)(ws + WS_WQKV), QKVN, 1024, SE, tid, lane, wave, G, bx); } SEAM(13);
    if (IN(14)) REPLOOP(14) { phase_rope(P, tid); } SEAM(14);
    if (IN(15)) REPLOOP(15) {
        const int NPU = 16 * (LP / 256), NSU = NS * 16 / 2;
        for (int u = bx; u < NSU; u += G) attn_sample_unit(P, lds, u, lane, wave);
        for (int u = bx; u < NPU; u += G) { int hh, tb; if ((G & 7) == 0 && NPU % G == 0) { const int x = u & 7, li = (u % G) >> 3, rho = u / G, per = G >> 3;
                const int idx = rho * per + li; hh = 2 * x + (idx & 1); tb = idx >> 1; } else { hh = u & 15; tb = u >> 4; }
            attn_prompt_unit(P, lds, hh, tb, tid, lane, wave); }
    } SEAM(15);
    if (IN(16)) REPLOOP(16) { pg8::EpiResid E{(float*)(ws + WS_X), (const float*)(ws + WS_MOD) + MODL + 2 * 1024, MODROW, LP, MV}; GEMM_PHASE(pg8::EpiResid, WS_ATT, WS_WO, LP, 1024, 1024, E);
        SEpiResid SE{(float*)(ws + WS_X), (const float*)(ws + WS_MOD) + MODL + 2 * 1024, MODROW}; sample_gemm_units(lds, (const bf16*)(ws + WS_ATT), 1024, (const bf16*)(ws + WS_WO), 1024, 1024, SE, tid, lane, wave, G, bx); } SEAM(16);
    if (IN(17)) REPLOOP(17) { phase_norm<false>(P, 1, 1, lane, wave); } SEAM(17);
    if (IN(18)) REPLOOP(18) { pg8::EpiStore E{(bf16*)(ws + WS_UP), UPN, 1 << 30}; GEMM_PHASE(pg8::EpiStore, WS_H, WS_WUP1, LP, UPN, 1024, E);
        SEpiStore SE{(bf16*)(ws + WS_UP), UPN, 1 << 30}; sample_gemm_units(lds, (const bf16*)(ws + WS_H), 1024, (const bf16*)(ws + WS_WUP1), UPN, 1024, SE, tid, lane, wave, G, bx); } SEAM(18);
    if (IN(19)) REPLOOP(19) { phase_conv(P, 1, tid); } SEAM(19);
    if (IN(20)) REPLOOP(20) { pg8::EpiResid E{(float*)(ws + WS_X), (const float*)(ws + WS_MOD) + MODL + 5 * 1024, MODROW, LP, MV}; GEMM_PHASE(pg8::EpiResid, WS_ACT, WS_WDN1, LP, 1024, DFF, E);
        SEpiResid SE{(float*)(ws + WS_X), (const float*)(ws + WS_MOD) + MODL + 5 * 1024, MODROW}; sample_gemm_units(lds, (const bf16*)(ws + WS_ACT), DFF, (const bf16*)(ws + WS_WDN1), 1024, DFF, SE, tid, lane, wave, G, bx); } SEAM(20);
    if (IN(21)) REPLOOP(21) { phase_final_norm(P, lane, wave); }
#undef IN
#undef SEAM
#undef GEMM_PHASE
}

#ifndef N_LAUNCH_MODE
#define N_LAUNCH_MODE 1
#endif
extern "C" void kernel_launch(void* const* d_in, const int* in_sizes, int n_in, void* d_out, int out_size, void* d_ws, size_t ws_size, hipStream_t stream) {
    static int grid = 0;
    if (grid == 0) {
        if (n_in != N_IN || out_size != (int)O_TOTAL || ws_size < WS_END) { fprintf(stderr, "kernel_launch: unexpected shapes (n_in %d, out %d, ws %zu)\n", n_in, out_size, ws_size); grid = -1; return; }
        int dev = 0, cus = 0, per_cu = 0;
        if (hipGetDevice(&dev) != hipSuccess || hipDeviceGetAttribute(&cus, hipDeviceAttributeMultiprocessorCount, dev) != hipSuccess) { grid = -1; return; }
        if (hipFuncSetAttribute((const void*)mega_fwd, hipFuncAttributeMaxDynamicSharedMemorySize, LDS_BYTES) != hipSuccess) { fprintf(stderr, "kernel_launch: hipFuncSetAttribute failed\n"); grid = -1; return; }
        if (hipOccupancyMaxActiveBlocksPerMultiprocessor(&per_cu, (const void*)mega_fwd, 512, LDS_BYTES) != hipSuccess || per_cu < 1) { fprintf(stderr, "kernel_launch: occupancy query says %d\n", per_cu); per_cu = 1; }
        (void)hipGetLastError();
        grid = cus;
    }
    if (grid < 0) return;
    if (hipMemsetAsync((char*)d_ws + WS_CTL, 0, 1 * MiB, stream) != hipSuccess) { fprintf(stderr, "kernel_launch: memset failed\n"); return; }
    Params p{};
    for (int i = 0; i < N_IN; ++i) p.in[i] = (const float*)d_in[i];
    p.out = (float*)d_out; p.ws = (unsigned char*)d_ws;
#if N_LAUNCH_MODE == 1
    p.ph_lo = 0; p.ph_hi = NPHASE;
    void* args[] = {&p};
    hipError_t e = hipLaunchCooperativeKernel((const void*)mega_fwd, dim3(grid), dim3(512), args, LDS_BYTES, stream);
    if (e != hipSuccess) fprintf(stderr, "kernel_launch: cooperative launch failed: %s (grid %d)\n", hipGetErrorString(e), grid);
#else
    for (int ph = 0; ph < NPHASE; ++ph) { p.ph_lo = ph; p.ph_hi = ph + 1; hipLaunchKernelGGL(mega_fwd, dim3(grid), dim3(512), LDS_BYTES, stream, p); }
#endif
}
```

```cpp
#include <hip/hip_runtime.h>
#include <hip/hip_cooperative_groups.h>
#include <cstdio>
#include <cstdint>
namespace pg8 {
#define PG8_LAS __attribute__((address_space(3)))
typedef unsigned short bf16_t;
typedef short bf16x8 __attribute__((ext_vector_type(8)));
typedef float f32x4 __attribute__((ext_vector_type(4)));
typedef unsigned u32x4 __attribute__((ext_vector_type(4)));
constexpr int BM = 256, BK = 64, HALF = 128, HTB = HALF * BK * 2  , STAGE_BYTES = 8 * HTB, NXCD = 8, WGM = 8;

__host__ __device__ __forceinline__ int lds_byte(int r, int c) { const int st = (r >> 4) * 2 + (c >> 5), rr = r & 15, cc = c & 31, ob = rr * 64 + cc * 2; return st * 1024 + (ob ^ (((ob >> 9) & 1) << 5)); }
__host__ __device__ __forceinline__ void stage_rc(int b, int& R, int& C) { const int st = b / 1024, sb = b % 1024, swz = sb ^ (((sb >> 9) & 1) << 5); R = (st >> 1) * 16 + swz / 64; C = (st & 1) * 32 + (swz % 64) / 2; }
__host__ __device__ __forceinline__ int perm32(int rho) { const int n = rho >> 4, i = rho & 15; return 8 * (i >> 2) + 4 * n + (i & 3); }

struct Unit { int pm, pn; };
struct Gemm { const bf16_t* A; const bf16_t* Bt; int M, N, K; };

struct StaticOrder {
    int nM, nN, nwg, G, c;
    __host__ __device__ void init(int M, int N, int G_, int c_) { nM = M / BM; nN = N / BM; nwg = nM * nN; G = G_; c = c_; }
    __host__ __device__ bool next(int i, Unit& u) const {
        const long L = (long)i * G + c; if (L >= nwg) return false;
        int wgid = (int)L; { const int q = nwg / NXCD, r = nwg % NXCD, xcd = wgid % NXCD, off = wgid / NXCD; wgid = (xcd < r ? xcd * (q + 1) : r * (q + 1) + (xcd - r) * q) + off; }
        const int nig = WGM * nN, gid = wgid / nig, fm = gid * WGM, gsz = (nM - fm) < WGM ? (nM - fm) : WGM;
        u.pm = fm + ((wgid % nig) % gsz); u.pn = (wgid % nig) / gsz; return true;
    }
    __device__ __forceinline__ void a_ready(const Unit&) const {}
    __device__ __forceinline__ void done(const Unit&) const {}
};

__device__ __forceinline__ unsigned cvt_pk_bf16(float lo, float hi) { unsigned r; asm volatile("v_cvt_pk_bf16_f32 %0, %1, %2" : "=v"(r) : "v"(lo), "v"(hi)); return r; }
typedef float f32x2 __attribute__((ext_vector_type(2)));
__device__ __forceinline__ float gelu_tanh(float x) {
    const float u = x * (1.5957691216f + 0.0713548163f * x * x);
    return x / (1.0f + __expf(-u));
}
__device__ __forceinline__ float sigmoidf_(float x) { return 1.0f / (1.0f + __expf(-x)); }
__device__ __forceinline__ float bf2f(unsigned short b) { return __uint_as_float(((unsigned)b) << 16); }

struct EpiStore {
    static constexpr bool PERM = true, AFTER_DRAIN = false;
    bf16_t* O; int ldc; int gelu_from;
    __device__ __forceinline__ void operator()(const f32x4 (&acc)[2][2][4][2], const Unit& u, int wr, int wc, int fr, int fq) const {
        const int row0 = u.pm * BM + wr * 64 + fr, col0 = u.pn * BM + wc * 32 + 8 * fq;
        const bool act = (u.pn * BM) >= gelu_from;
#pragma unroll
        for (int ai = 0; ai < 2; ++ai)
#pragma unroll
            for (int m = 0; m < 4; ++m) { bf16_t* rowp = O + (size_t)(row0 + ai * HALF + m * 16) * ldc + col0;
#pragma unroll
                for (int bj = 0; bj < 2; ++bj) { f32x4 v0 = acc[ai][bj][m][0], v1 = acc[ai][bj][m][1];
                    if (act) {
#pragma unroll
                        for (int e = 0; e < 4; ++e) { v0[e] = gelu_tanh(v0[e]); v1[e] = gelu_tanh(v1[e]); } }
                    u32x4 w; w.x = cvt_pk_bf16(v0[0], v0[1]); w.y = cvt_pk_bf16(v0[2], v0[3]); w.z = cvt_pk_bf16(v1[0], v1[1]); w.w = cvt_pk_bf16(v1[2], v1[3]);
                    *(u32x4*)(rowp + bj * HALF) = w; } }
    }
};
struct EpiGlu {
    static constexpr bool PERM = true, AFTER_DRAIN = false;
    bf16_t* O; int ldc; const bf16_t* Y; int ldy; const float* bias;
    __device__ __forceinline__ void operator()(const f32x4 (&acc)[2][2][4][2], const Unit& u, int wr, int wc, int fr, int fq) const {
        const int row0 = u.pm * BM + wr * 64 + fr, col0 = u.pn * BM + wc * 32 + 8 * fq;
#pragma unroll
        for (int ai = 0; ai < 2; ++ai)
#pragma unroll
            for (int m = 0; m < 4; ++m) { const size_t r = (size_t)(row0 + ai * HALF + m * 16);
#pragma unroll
                for (int bj = 0; bj < 2; ++bj) { const int c = col0 + bj * HALF;
                    const f32x4 b0 = *(const f32x4*)(bias + c), b1 = *(const f32x4*)(bias + c + 4);
                    const u32x4 yw = *(const u32x4*)(Y + r * ldy + c);
                    f32x4 v0 = acc[ai][bj][m][0] + b0, v1 = acc[ai][bj][m][1] + b1;
                    float y[8]; y[0] = __uint_as_float(yw.x << 16); y[1] = __uint_as_float(yw.x & 0xffff0000u); y[2] = __uint_as_float(yw.y << 16); y[3] = __uint_as_float(yw.y & 0xffff0000u);
                    y[4] = __uint_as_float(yw.z << 16); y[5] = __uint_as_float(yw.z & 0xffff0000u); y[6] = __uint_as_float(yw.w << 16); y[7] = __uint_as_float(yw.w & 0xffff0000u);
#pragma unroll
                    for (int e = 0; e < 4; ++e) { v0[e] = y[e] * sigmoidf_(v0[e]); v1[e] = y[4 + e] * sigmoidf_(v1[e]); }
                    u32x4 w; w.x = cvt_pk_bf16(v0[0], v0[1]); w.y = cvt_pk_bf16(v0[2], v0[3]); w.z = cvt_pk_bf16(v1[0], v1[1]); w.w = cvt_pk_bf16(v1[2], v1[3]);
                    *(u32x4*)(O + r * ldc + c) = w; } }
    }
};
struct EpiResid {
    static constexpr bool PERM = false, AFTER_DRAIN = false;
    float* X; const float* gate; int gstride; int lp; int mvalid;
    __device__ __forceinline__ void operator()(const f32x4 (&acc)[2][2][4][2], const Unit& u, int wr, int wc, int fr, int fq) const {
        const int row0 = u.pm * BM + wr * 64 + fr, col0 = u.pn * BM + wc * 32 + 4 * fq;
#pragma unroll
        for (int ai = 0; ai < 2; ++ai)
#pragma unroll
            for (int m = 0; m < 4; ++m) { const int r = row0 + ai * HALF + m * 16;
                if (r < mvalid) { const int mrow = r < lp ? 0 : (r - lp + 1); const float* gp = gate + (size_t)mrow * gstride; float* xp = X + (size_t)r * 1024;
#pragma unroll
                    for (int bj = 0; bj < 2; ++bj)
#pragma unroll
                        for (int n = 0; n < 2; ++n) { const int c = col0 + bj * HALF + n * 16; const f32x4 g = *(const f32x4*)(gp + c); f32x4 x = *(const f32x4*)(xp + c); x = x + g * acc[ai][bj][m][n]; *(f32x4*)(xp + c) = x; } } }
    }
};

__device__ __forceinline__ float dpp_ror1(float x) { return __builtin_bit_cast(float, __builtin_amdgcn_update_dpp(0, __builtin_bit_cast(int, x), 0x121, 0xf, 0xf, true)); }
__device__ __forceinline__ float dpp_ror2(float x) { return __builtin_bit_cast(float, __builtin_amdgcn_update_dpp(0, __builtin_bit_cast(int, x), 0x122, 0xf, 0xf, true)); }
struct EpiUpConv {
    static constexpr bool PERM = true, AFTER_DRAIN = false;
    bf16_t* ACT; int ldc; const float* cw; const float* cb; int dff; float* HEAD; float* TAIL; PG8_LAS float* xch;
    __device__ __forceinline__ void operator()(const f32x4 (&acc)[2][2][4][2], const Unit& u, int wr, int wc, int fr, int fq) const {
        const int ch0 = u.pn * HALF + wc * 32 + 8 * fq;
        if (fr >= 14) {
#pragma unroll
            for (int ai = 0; ai < 2; ++ai)
#pragma unroll
                for (int n = 0; n < 2; ++n) *(PG8_LAS f32x4*)(xch + (((ai * 2 + wr) * 4 + wc) * 2 + (fr - 14)) * 32 + fq * 8 + 4 * n) = acc[ai][0][3][n];
        }
        asm volatile("s_waitcnt lgkmcnt(0)" ::: "memory"); __builtin_amdgcn_s_barrier(); asm volatile("" ::: "memory");
        float w0[8], w1[8], w2[8], bb[8];
#pragma unroll
        for (int n = 0; n < 2; ++n) { const f32x4 a = *(const f32x4*)(cw + ch0 + 4 * n), b = *(const f32x4*)(cw + dff + ch0 + 4 * n), c = *(const f32x4*)(cw + 2 * dff + ch0 + 4 * n), d = *(const f32x4*)(cb + ch0 + 4 * n);
#pragma unroll
            for (int e = 0; e < 4; ++e) { w0[4 * n + e] = a[e]; w1[4 * n + e] = b[e]; w2[4 * n + e] = c[e]; bb[4 * n + e] = d[e]; } }
#pragma unroll
        for (int ai = 0; ai < 2; ++ai) {
            float p1[8], p2[8];
            if (ai == 0 && wr == 0) {
#pragma unroll
                for (int k = 0; k < 8; ++k) { p1[k] = 0.f; p2[k] = 0.f; }
            } else { const int pai = wr == 1 ? ai : ai - 1, pwr = wr ^ 1; const PG8_LAS float* xp = xch + (((pai * 2 + pwr) * 4 + wc) * 2) * 32 + fq * 8;
#pragma unroll
                for (int n = 0; n < 2; ++n) { const f32x4 l14 = *(const PG8_LAS f32x4*)(xp + 4 * n), l15 = *(const PG8_LAS f32x4*)(xp + 32 + 4 * n);
#pragma unroll
                    for (int e = 0; e < 4; ++e) { p1[4 * n + e] = l15[e]; p2[4 * n + e] = fr == 0 ? l14[e] : l15[e]; } } }
#pragma unroll
            for (int m = 0; m < 4; ++m) { const int r = u.pm * BM + ai * HALF + wr * 64 + m * 16 + fr;
                float a[8], g[8], o[8];
#pragma unroll
                for (int n = 0; n < 2; ++n)
#pragma unroll
                    for (int e = 0; e < 4; ++e) { a[4 * n + e] = acc[ai][0][m][n][e]; g[4 * n + e] = acc[ai][1][m][n][e]; }
#pragma unroll
                for (int k = 0; k < 8; ++k) { const float x1 = dpp_ror1(a[k]), x2 = dpp_ror2(a[k]); const float pr1 = fr >= 1 ? x1 : p1[k], pr2 = fr >= 2 ? x2 : p2[k];
                    const float y = bb[k] + w0[k] * pr2 + w1[k] * pr1 + w2[k] * a[k]; o[k] = gelu_tanh(y) * g[k]; p1[k] = x1; p2[k] = x2; }
                const bool head = (ai == 0 && wr == 0 && m == 0 && fr < 2 && u.pm > 0);
                if (!head) { u32x4 w; w.x = cvt_pk_bf16(o[0], o[1]); w.y = cvt_pk_bf16(o[2], o[3]); w.z = cvt_pk_bf16(o[4], o[5]); w.w = cvt_pk_bf16(o[6], o[7]);
                    *(u32x4*)(ACT + (size_t)r * ldc + ch0) = w; }
                else { float* hp = HEAD + ((size_t)(u.pm * 2 + fr) * 2) * dff + ch0;
#pragma unroll
                    for (int n = 0; n < 2; ++n) { *(f32x4*)(hp + 4 * n) = acc[ai][0][m][n]; *(f32x4*)(hp + dff + 4 * n) = acc[ai][1][m][n]; } }
                if (ai == 1 && wr == 1 && m == 3 && fr >= 14) { float* tp = TAIL + (size_t)(u.pm * 2 + fr - 14) * dff + ch0;
#pragma unroll
                    for (int n = 0; n < 2; ++n) *(f32x4*)(tp + 4 * n) = acc[ai][0][m][n]; }
            }
        }
    }
};
template <class Epi, class Sched, bool ALIGN_EPI = false, bool SP2 = false>
__device__ __forceinline__ void gemm_phase(PG8_LAS unsigned char* lds, const Gemm g, const Sched& S, const Epi& E) {
    const int tid = threadIdx.x, wid = __builtin_amdgcn_readfirstlane(tid >> 6), lane = tid & 63, wr = wid >> 2, wc = wid & 3, fr = lane & 15, fq = lane >> 4;
    const int K = g.K, nt = K / BK;
    unsigned voffA[2], voffB[2];
#pragma unroll
    for (int i = 0; i < 2; ++i) { int R, C; stage_rc(tid * 16 + i * 8192, R, C); const int Rb = Epi::PERM ? ((R & ~31) + perm32(R & 31)) : R;
        voffA[i] = (unsigned)(R * K + C) * 2u; voffB[i] = (unsigned)(Rb * K + C) * 2u; }
    const size_t kstep = (size_t)(BK * 2);
    const size_t hstep = (size_t)HALF * K * 2;
    const size_t tstep = 2 * hstep;
    const unsigned ldsw = (unsigned)wid * 1024u;
    const int aoff = lds_byte(wr * 64 + fr, fq * 8), boff = lds_byte(wc * 32 + fr, fq * 8);
#define PG8_SA(b, h) (((b) * 2 + (h)) * HTB)
#define PG8_SB(b, h) ((4 + (b) * 2 + (h)) * HTB)
#define PG8_STAGE(bufoff, gbase, voff) do { _Pragma("unroll") for (int _i = 0; _i < 2; ++_i) \
        __builtin_amdgcn_global_load_lds((const unsigned*)((const char*)(gbase) + (voff)[_i]), (PG8_LAS unsigned*)(lds + (bufoff) + ldsw + _i * 8192), 16, 0, 0); } while (0)
#define PG8_LDA(dst, b, h) do { _Pragma("unroll") for (int m = 0; m < 4; ++m) _Pragma("unroll") for (int k = 0; k < 2; ++k) dst[m][k] = *(const PG8_LAS bf16x8*)(lds + PG8_SA(b, h) + aoff + m * 2048 + k * 1024); } while (0)
#define PG8_LDB(dst, b, h) do { _Pragma("unroll") for (int n = 0; n < 2; ++n) _Pragma("unroll") for (int k = 0; k < 2; ++k) dst[n][k] = *(const PG8_LAS bf16x8*)(lds + PG8_SB(b, h) + boff + n * 2048 + k * 1024); } while (0)
#define PG8_MMA(ai, bj, At, Bt) do { __builtin_amdgcn_s_setprio(1); _Pragma("unroll") for (int m = 0; m < 4; ++m) _Pragma("unroll") for (int n = 0; n < 2; ++n) _Pragma("unroll") for (int k = 0; k < 2; ++k) \
        acc[ai][bj][m][n] = __builtin_amdgcn_mfma_f32_16x16x32_bf16(Bt[n][k], At[m][k], acc[ai][bj][m][n], 0, 0, 0); __builtin_amdgcn_s_setprio(0); } while (0)
#define PG8_WAIT_V(n) asm volatile("s_waitcnt vmcnt(" #n ")" ::: "memory")
#define PG8_WAIT_L(n) asm volatile("s_waitcnt lgkmcnt(" #n ")" ::: "memory")
#define PG8_BAR __builtin_amdgcn_s_barrier()
#define PG8_SCHED __builtin_amdgcn_sched_barrier(0)
    Unit cur, nxt; int ui = 0;
    if (!S.next(0, cur)) return;
    f32x4 acc[2][2][4][2];
#pragma unroll
    for (int a = 0; a < 2; ++a)
#pragma unroll
        for (int b = 0; b < 2; ++b)
#pragma unroll
            for (int m = 0; m < 4; ++m)
#pragma unroll
                for (int n = 0; n < 2; ++n) acc[a][b][m][n] = (f32x4){0.f, 0.f, 0.f, 0.f};
    bf16x8 At[4][2], B0[2][2], B1[2][2];
    const char* cA = (const char*)g.A + (size_t)cur.pm * tstep; const char* cB = (const char*)g.Bt + (size_t)cur.pn * tstep;
    S.a_ready(cur);
    if constexpr (SP2) {
        PG8_STAGE(PG8_SB(0, 0), cB, voffB); PG8_STAGE(PG8_SB(0, 1), cB + hstep, voffB); PG8_STAGE(PG8_SA(0, 0), cA, voffA); PG8_STAGE(PG8_SA(0, 1), cA + hstep, voffA);
        if (wr == 1) PG8_BAR;
        PG8_WAIT_V(2); PG8_BAR;
        PG8_STAGE(PG8_SB(1, 0), cB + kstep, voffB); PG8_STAGE(PG8_SA(1, 0), cA + kstep, voffA); PG8_STAGE(PG8_SB(1, 1), cB + hstep + kstep, voffB);
        PG8_WAIT_V(6); PG8_BAR;
    } else {
        PG8_STAGE(PG8_SB(0, 0), cB, voffB); PG8_STAGE(PG8_SA(0, 0), cA, voffA); PG8_STAGE(PG8_SB(0, 1), cB + hstep, voffB); PG8_STAGE(PG8_SA(0, 1), cA + hstep, voffA);
        if (wr == 1) PG8_BAR;
        PG8_WAIT_V(4); PG8_BAR;
        PG8_STAGE(PG8_SB(1, 0), cB + kstep, voffB); PG8_STAGE(PG8_SA(1, 0), cA + kstep, voffA); PG8_STAGE(PG8_SB(1, 1), cB + hstep + kstep, voffB);
        PG8_WAIT_V(6); PG8_BAR;
    }
    for (;;) {
        const bool has_next = S.next(ui + 1, nxt);
        const char* nA = has_next ? (const char*)g.A + (size_t)nxt.pm * tstep : cA; const char* nB = has_next ? (const char*)g.Bt + (size_t)nxt.pn * tstep : cB;
        for (int t = 0; t < nt; t += 2) {
            const bool last = (t == nt - 2);
            const char* a1 = cA + (size_t)(t + 1) * kstep;
            const char* a2 = last ? nA : cA + (size_t)(t + 2) * kstep; const char* b2 = last ? nB : cB + (size_t)(t + 2) * kstep;
            const char* a3 = a2 + kstep; const char* b3 = b2 + kstep;
            if (last && has_next) S.a_ready(nxt);
            if constexpr (SP2) {
            PG8_LDB(B0, 0, 0); PG8_LDB(B1, 0, 1); PG8_SCHED; PG8_LDA(At, 0, 0); PG8_STAGE(PG8_SA(1, 1), a1 + hstep, voffA);
            PG8_WAIT_V(8); PG8_WAIT_L(0); PG8_BAR; PG8_MMA(0, 0, At, B0); PG8_MMA(0, 1, At, B1); PG8_BAR; PG8_SCHED;
            PG8_LDA(At, 0, 1); PG8_STAGE(PG8_SB(0, 0), b2, voffB); PG8_STAGE(PG8_SB(0, 1), b2 + hstep, voffB); PG8_STAGE(PG8_SA(0, 0), a2, voffA);
            PG8_WAIT_V(8); PG8_WAIT_L(0); PG8_BAR; PG8_MMA(1, 0, At, B0); PG8_MMA(1, 1, At, B1); PG8_BAR; PG8_SCHED;
            PG8_LDB(B0, 1, 0); PG8_LDB(B1, 1, 1); PG8_SCHED; PG8_LDA(At, 1, 0); PG8_STAGE(PG8_SA(0, 1), a2 + hstep, voffA);
            PG8_WAIT_V(8); PG8_WAIT_L(0); PG8_BAR; PG8_MMA(0, 0, At, B0); PG8_MMA(0, 1, At, B1); PG8_BAR; PG8_SCHED;
            PG8_LDA(At, 1, 1); PG8_STAGE(PG8_SB(1, 0), b3, voffB); PG8_STAGE(PG8_SB(1, 1), b3 + hstep, voffB); PG8_STAGE(PG8_SA(1, 0), a3, voffA);
            PG8_WAIT_V(8); PG8_WAIT_L(0); PG8_BAR; PG8_MMA(1, 0, At, B0); PG8_MMA(1, 1, At, B1); PG8_BAR; PG8_SCHED;
            } else {
            PG8_LDB(B0, 0, 0); PG8_SCHED; PG8_LDA(At, 0, 0); PG8_STAGE(PG8_SA(1, 1), a1 + hstep, voffA);
            PG8_WAIT_L(8); PG8_BAR; PG8_WAIT_L(0); PG8_MMA(0, 0, At, B0); PG8_BAR; PG8_SCHED;
            PG8_LDB(B1, 0, 1); PG8_STAGE(PG8_SB(0, 0), b2, voffB);
            PG8_BAR; PG8_WAIT_L(0); PG8_MMA(0, 1, At, B1); PG8_BAR;
            PG8_LDA(At, 0, 1); PG8_STAGE(PG8_SA(0, 0), a2, voffA);
            PG8_BAR; PG8_WAIT_L(0); PG8_MMA(1, 0, At, B0); PG8_BAR; PG8_SCHED;
            PG8_STAGE(PG8_SB(0, 1), b2 + hstep, voffB);
            PG8_WAIT_V(6); PG8_BAR; PG8_MMA(1, 1, At, B1); PG8_BAR;
            PG8_LDB(B0, 1, 0); PG8_SCHED; PG8_LDA(At, 1, 0); PG8_STAGE(PG8_SA(0, 1), a2 + hstep, voffA);
            PG8_WAIT_L(8); PG8_BAR; PG8_WAIT_L(0); PG8_MMA(0, 0, At, B0); PG8_BAR; PG8_SCHED;
            PG8_LDB(B1, 1, 1); PG8_STAGE(PG8_SB(1, 0), b3, voffB);
            PG8_BAR; PG8_WAIT_L(0); PG8_MMA(0, 1, At, B1); PG8_BAR;
            PG8_LDA(At, 1, 1); PG8_STAGE(PG8_SA(1, 0), a3, voffA);
            PG8_BAR; PG8_WAIT_L(0); PG8_MMA(1, 0, At, B0); PG8_BAR; PG8_SCHED;
            PG8_STAGE(PG8_SB(1, 1), b3 + hstep, voffB);
            PG8_WAIT_V(6); PG8_BAR; PG8_MMA(1, 1, At, B1); PG8_BAR;
            }
        }
        if constexpr (ALIGN_EPI) { if (wr == 0) PG8_BAR; }
        if constexpr (!Epi::AFTER_DRAIN) { E(acc, cur, wr, wc, fr, fq); S.done(cur); }
        if (!has_next) break;
#pragma unroll
        for (int a = 0; a < 2; ++a)
#pragma unroll
            for (int b = 0; b < 2; ++b)
#pragma unroll
                for (int m = 0; m < 4; ++m)
#pragma unroll
                    for (int n = 0; n < 2; ++n) acc[a][b][m][n] = (f32x4){0.f, 0.f, 0.f, 0.f};
        cur = nxt; cA = nA; cB = nB; ++ui;
        if constexpr (ALIGN_EPI) { if (wr == 1) PG8_BAR; }
    }
    PG8_WAIT_V(0);
    if constexpr (!ALIGN_EPI) { if (wr == 0) PG8_BAR; }
    PG8_BAR;
    if constexpr (Epi::AFTER_DRAIN) { E.fused(acc, cur, wr, wc, fr, fq, lds, wid, lane); S.done(cur); }
#undef PG8_SA
#undef PG8_SB
#undef PG8_STAGE
#undef PG8_LDA
#undef PG8_LDB
#undef PG8_MMA
#undef PG8_WAIT_V
#undef PG8_WAIT_L
#undef PG8_BAR
#undef PG8_SCHED
}
}
namespace cg = cooperative_groups;
#define LAS __attribute__((address_space(3)))
typedef unsigned short bf16;
typedef float f32x4 __attribute__((ext_vector_type(4)));
typedef unsigned u32x4 __attribute__((ext_vector_type(4)));
typedef unsigned u32x2 __attribute__((ext_vector_type(2)));

typedef short bf16x8v __attribute__((ext_vector_type(8)));
typedef short s16x4v __attribute__((ext_vector_type(4)));

constexpr int DM = 1024, LP = 16384, NS = 32, MV = LP + NS, MT = 16640;
constexpr int EIN = 1536, DFF = 2816, UPN = 5632, QKVN = 3072;
constexpr int NG = 32, NST = 64;
constexpr int CH = 128, NCH = LP / CH;
constexpr int MODROW = 6144, MODL = 33 * MODROW;
constexpr float EPS = 1e-6f;

enum { I_XP = 0, I_XS, I_CP, I_CS, I_S5RE, I_S5IM, I_CK, I_CV, I_CONV, I_ADAW, I_ADAB, I_NORMG, I_FING, I_WIN, I_WOUT, I_LAMRE, I_LAMIM, I_LOGDT, I_BRE, I_BIM, I_CRE, I_CIM,
       I_S5D, I_WGLU, I_BGLU, I_LNG, I_LNB, I_SGW, I_SGB, I_WQKV, I_WO, I_WUP, I_CONVW, I_CONVB, I_WDN, N_IN };
constexpr size_t O_YP = 0, O_YS = 16777216, O_S5RP = 16809984, O_S5IP = 16812032, O_S5RS = 16814080, O_S5IS = 16879616, O_SGUV = 16945152, O_KP = 16961536, O_VP = 19058688,
                 O_KS = 21155840, O_VS = 21188608, O_CONVP = 21221376, O_CONVS = 21232640, O_TOTAL = 21593088;
constexpr size_t MiB = 1u << 20;
constexpr size_t WS_CTL = 0, WS_WIN = 1 * MiB, WS_WGLU = 4 * MiB, WS_WOUT = 5 * MiB, WS_WQKV = 7 * MiB, WS_WO = 13 * MiB, WS_WUP0 = 15 * MiB, WS_WUP1 = 26 * MiB, WS_WDN0 = 37 * MiB,
                 WS_WDN1 = 43 * MiB, WS_MOD = 49 * MiB, WS_S5A = 51 * MiB, WS_S5BB = 52 * MiB, WS_KTAB = 53 * MiB, WS_ETAB = 54 * MiB, WS_G1 = 56 * MiB, WS_HEAD = 58 * MiB, WS_TAIL = 61 * MiB, WS_X = 64 * MiB, WS_H = 130 * MiB, WS_PROJ = 164 * MiB,
                 WS_Y = 214 * MiB, WS_MIX = 232 * MiB, WS_UP = 266 * MiB, WS_ACT = 446 * MiB, WS_QKV = 537 * MiB, WS_ATT = 636 * MiB, WS_SBUF = 670 * MiB, WS_HCAT = 686 * MiB, WS_END = 694 * MiB;
constexpr int LDS_BYTES = 147456;
constexpr int NPHASE = 22;

struct Params { const float* in[N_IN]; float* out; unsigned char* ws; int ph_lo, ph_hi; };

__device__ __forceinline__ unsigned f2bf(float f) { unsigned u = __builtin_bit_cast(unsigned, f); return (u + 0x7fffu + ((u >> 16) & 1u)) >> 16; }
__device__ __forceinline__ unsigned pk2(float lo, float hi) { return f2bf(lo) | (f2bf(hi) << 16); }
__device__ __forceinline__ float bflo(unsigned w) { return __uint_as_float(w << 16); }
__device__ __forceinline__ float bfhi(unsigned w) { return __uint_as_float(w & 0xffff0000u); }
__device__ __forceinline__ void unpack8(const u32x4 w, float (&f)[8]) { f[0] = bflo(w.x); f[1] = bfhi(w.x); f[2] = bflo(w.y); f[3] = bfhi(w.y); f[4] = bflo(w.z); f[5] = bfhi(w.z); f[6] = bflo(w.w); f[7] = bfhi(w.w); }
__device__ __forceinline__ float wave_sum(float v) {
#pragma unroll
    for (int o = 1; o < 64; o <<= 1) v += __shfl_xor(v, o);
    return v;
}
__device__ __forceinline__ float wave_max(float v) {
#pragma unroll
    for (int o = 1; o < 64; o <<= 1) v = fmaxf(v, __shfl_xor(v, o));
    return v;
}
__device__ __forceinline__ void sincos_red(float ang, float& s, float& c) {
    const double a = (double)ang; const double n = __builtin_rint(a * 0.15915494309189535); const float r = (float)(a - n * 6.283185307179586);
    s = __sinf(r); c = __cosf(r);
}
__device__ __forceinline__ float gelu_t(float x) { return pg8::gelu_tanh(x); }

__device__ __forceinline__ void s5_disc(const Params& P, int chn, float& ar, float& ai, float& fr, float& fi) {
    const float dt = expf(P.in[I_LOGDT][chn >> 6]), lr = P.in[I_LAMRE][chn], li = P.in[I_LAMIM][chn];
    const float mag = expf(lr * dt); float sn, cs; sincos_red(li * dt, sn, cs);
    ar = mag * cs; ai = mag * sn; const float den = lr * lr + li * li;
    fr = ((ar - 1.0f) * lr + ai * li) / den; fi = (ai * lr - (ar - 1.0f) * li) / den;
}
template <bool UPMAP = false> __device__ __forceinline__ void transpose_item(const float* W, int K, int N, bf16* WT, LAS float* scr, int item, int lane) {
    const int nblk = N / 32, kb = item / nblk, nb = item % nblk, k0 = 64 * kb, n0 = 32 * nb;
    const int nd0 = UPMAP ? (n0 < DFF ? 256 * (n0 / 128) + n0 % 128 : 256 * ((n0 - DFF) / 128) + 128 + (n0 - DFF) % 128) : n0;
    float tv[32];
#pragma unroll
    for (int i = 0; i < 32; ++i) tv[i] = W[(size_t)(k0 + 2 * i + (lane >> 5)) * N + n0 + (lane & 31)];
#pragma unroll
    for (int i = 0; i < 32; ++i) scr[(2 * i + (lane >> 5)) * 33 + (lane & 31)] = tv[i];
    asm volatile("s_waitcnt lgkmcnt(0)" ::: "memory");
    const int c = lane & 7;
#pragma unroll
    for (int j = 0; j < 4; ++j) { const int n = (lane >> 3) + 8 * j; const LAS float* s = scr + (8 * c) * 33 + n;
        u32x4 o; o.x = pk2(s[0 * 33], s[1 * 33]); o.y = pk2(s[2 * 33], s[3 * 33]); o.z = pk2(s[4 * 33], s[5 * 33]); o.w = pk2(s[6 * 33], s[7 * 33]);
        *(u32x4*)(WT + (size_t)(nd0 + n) * K + k0 + 8 * c) = o; }
    asm volatile("s_waitcnt lgkmcnt(0)" ::: "memory");
}
__device__ __forceinline__ void phase_prep(const Params& P, LAS unsigned char* lds, int tid, int lane, int wave) {
    unsigned char* ws = P.ws;
    {
        LAS float* scr = (LAS float*)(lds + wave * 16384);
        const int gw = blockIdx.x * 8 + wave, NGW = gridDim.x * 8;
        constexpr int I_IN = 16 * 48, I_GLU = 8 * 16, I_OUT = 16 * 32, I_QKV = 16 * 96, I_O = 16 * 32, I_UP = 16 * 176, I_DN = 44 * 32;
        constexpr int NITEMS = I_IN + I_GLU + I_OUT + I_QKV + I_O + 2 * I_UP + 2 * I_DN;
        for (int it = gw; it < NITEMS; it += NGW) {
            int r = it;
            if (r < I_IN) { transpose_item(P.in[I_WIN], 1024, EIN, (bf16*)(ws + WS_WIN), scr, r, lane); continue; } r -= I_IN;
            if (r < I_GLU) { transpose_item(P.in[I_WGLU], 512, 512, (bf16*)(ws + WS_WGLU), scr, r, lane); continue; } r -= I_GLU;
            if (r < I_OUT) { transpose_item(P.in[I_WOUT], 1024, 1024, (bf16*)(ws + WS_WOUT), scr, r, lane); continue; } r -= I_OUT;
            if (r < I_QKV) { transpose_item(P.in[I_WQKV], 1024, QKVN, (bf16*)(ws + WS_WQKV), scr, r, lane); continue; } r -= I_QKV;
            if (r < I_O) { transpose_item(P.in[I_WO], 1024, 1024, (bf16*)(ws + WS_WO), scr, r, lane); continue; } r -= I_O;
            if (r < I_UP) { transpose_item<true>(P.in[I_WUP], 1024, UPN, (bf16*)(ws + WS_WUP0), scr, r, lane); continue; } r -= I_UP;
            if (r < I_UP) { transpose_item<true>(P.in[I_WUP] + (size_t)1024 * UPN, 1024, UPN, (bf16*)(ws + WS_WUP1), scr, r, lane); continue; } r -= I_UP;
            if (r < I_DN) { transpose_item(P.in[I_WDN], DFF, 1024, (bf16*)(ws + WS_WDN0), scr, r, lane); continue; } r -= I_DN;
            transpose_item(P.in[I_WDN] + (size_t)DFF * 1024, DFF, 1024, (bf16*)(ws + WS_WDN1), scr, r, lane);
        }
    }
    __syncthreads();
    for (int unit = blockIdx.x; unit < 196 + 192; unit += gridDim.x) {
        if (unit < 192) {
            const int layer = unit / 96, col0 = (unit % 96) * 64;
            LAS float* sc = (LAS float*)lds;
            for (int idx = tid; idx < 33 * 1024; idx += 512) { const int row = idx >> 10, k = idx & 1023; const float c = row == 0 ? P.in[I_CP][k] : P.in[I_CS][(row - 1) * 1024 + k]; sc[idx] = c / (1.0f + __expf(-c)); }
            __syncthreads();
            float acc[33];
#pragma unroll
            for (int r = 0; r < 33; ++r) acc[r] = 0.f;
            const float* W = P.in[I_ADAW] + (size_t)layer * 1024 * MODROW + col0 + lane;
#pragma unroll 4
            for (int k = wave * 128; k < wave * 128 + 128; k += 4) { const float w0 = W[(size_t)k * MODROW], w1 = W[(size_t)(k + 1) * MODROW], w2 = W[(size_t)(k + 2) * MODROW], w3 = W[(size_t)(k + 3) * MODROW];
#pragma unroll
                for (int r = 0; r < 33; ++r) { const f32x4 s4 = *(const LAS f32x4*)(sc + r * 1024 + k); acc[r] += (s4.x * w0 + s4.y * w1) + (s4.z * w2 + s4.w * w3); } }
            __syncthreads();
            LAS float* part = (LAS float*)lds;
#pragma unroll
            for (int r = 0; r < 33; ++r) part[(wave * 33 + r) * 64 + lane] = acc[r];
            __syncthreads();
            for (int o = tid; o < 33 * 64; o += 512) { const int r = o >> 6, l = o & 63; float s = P.in[I_ADAB][layer * MODROW + col0 + l];
#pragma unroll
                for (int w = 0; w < 8; ++w) s += part[(w * 33 + r) * 64 + l];
                ((float*)(ws + WS_MOD))[(size_t)layer * MODL + r * MODROW + col0 + l] = s; }
            __syncthreads();
        } else if (unit < 196) {
            const int chn = (unit - 192) * 512 + tid;
            float ar, ai, fr, fi; s5_disc(P, chn, ar, ai, fr, fi);
            float* A2 = (float*)(ws + WS_S5A); A2[2 * chn] = ar; A2[2 * chn + 1] = ai;
            float pr = ar, pi = ai;
#pragma unroll
            for (int i = 0; i < 4; ++i) { const float nr = pr * pr - pi * pi, ni = 2.0f * pr * pi; pr = nr; pi = ni; }
            A2[4096 + 2 * chn] = pr; A2[4096 + 2 * chn + 1] = pi;
#pragma unroll
            for (int i = 0; i < 4; ++i) { const float nr = pr * pr - pi * pi, ni = 2.0f * pr * pi; pr = nr; pi = ni; }
            A2[8192 + 2 * chn] = pr; A2[8192 + 2 * chn + 1] = pi;
            float* BB = (float*)(ws + WS_S5BB) + (size_t)chn * 32;
#pragma unroll
            for (int p = 0; p < 16; ++p) { const float br = P.in[I_BRE][chn * 16 + p], bi = P.in[I_BIM][chn * 16 + p]; BB[p] = fr * br - fi * bi; BB[16 + p] = fr * bi + fi * br; }
        } else if (unit < 196 + 64) {
            const int id = (unit - 196) * 512 + tid, nq = id & 3, q = (id >> 2) & 15, p = (id >> 6) & 15, g = id >> 10;
            LAS float* la = (LAS float*)lds;
            LAS float* lb = la + 128;
            LAS float* lc = lb + 2048;
            if (tid < 64) { float ar, ai, fr, fi; s5_disc(P, g * 64 + tid, ar, ai, fr, fi); la[2 * tid] = ar; la[2 * tid + 1] = ai; la[4224 + 2 * tid] = fr; la[4224 + 2 * tid + 1] = fi; }
            __syncthreads();
#pragma unroll
            for (int it = 0; it < 2; ++it) { const int e = tid + 512 * it, n = e >> 4; const float br = P.in[I_BRE][(size_t)g * 1024 + e], bi = P.in[I_BIM][(size_t)g * 1024 + e], fr = la[4224 + 2 * n], fi = la[4224 + 2 * n + 1];
                lb[2 * e] = fr * br - fi * bi; lb[2 * e + 1] = fr * bi + fi * br;
                lc[2 * e] = P.in[I_CRE][(size_t)g * 1024 + e]; lc[2 * e + 1] = P.in[I_CIM][(size_t)g * 1024 + e]; }
            __syncthreads();
            float acc[16];
#pragma unroll
            for (int t = 0; t < 16; ++t) acc[t] = 0.f;
            for (int nn = 0; nn < 16; ++nn) { const int n = nq * 16 + nn;
                const float ar = la[2 * n], ai = la[2 * n + 1], bbr = lb[2 * (n * 16 + q)], bbi = lb[2 * (n * 16 + q) + 1], cr = lc[2 * (p * 64 + n)], ci = lc[2 * (p * 64 + n) + 1];
                float wr = cr * bbr - ci * bbi, wi = cr * bbi + ci * bbr;
#pragma unroll
                for (int t = 0; t < 16; ++t) { acc[t] += wr; const float nr = wr * ar - wi * ai, ni = wr * ai + wi * ar; wr = nr; wi = ni; } }
#pragma unroll
            for (int t = 0; t < 16; ++t) { acc[t] += __shfl_xor(acc[t], 1); acc[t] += __shfl_xor(acc[t], 2); }
            if (nq == 0) { acc[0] += (p == q) ? P.in[I_S5D][g * 16 + p] : 0.f; bf16* KT = (bf16*)(ws + WS_KTAB);
#pragma unroll
                for (int t = 0; t < 16; ++t) KT[((size_t)(g * 16 + t) * 16 + p) * 16 + q] = (bf16)f2bf(acc[t]); }
            __syncthreads();
        } else if (unit < 196 + 128) {
            const int id = (unit - 260) * 512 + tid, n = id & 63, p = (id >> 6) & 15, g = id >> 10, chn = g * 64 + n;
            float ar, ai, fr, fi; s5_disc(P, chn, ar, ai, fr, fi);
            const float cr = P.in[I_CRE][(size_t)(g * 16 + p) * 64 + n], ci = P.in[I_CIM][(size_t)(g * 16 + p) * 64 + n];
            float wr = cr * ar - ci * ai, wi = cr * ai + ci * ar; bf16* ET = (bf16*)(ws + WS_ETAB);
#pragma unroll
            for (int j = 0; j < 16; ++j) { bf16* e = ET + ((size_t)(g * 16 + j) * 16 + p) * 128; e[n] = (bf16)f2bf(wr); e[64 + n] = (bf16)f2bf(-wi);
                const float nr = wr * ar - wi * ai, ni = wr * ai + wi * ar; wr = nr; wi = ni; }
        } else {
            const int id = (unit - 324) * 512 + tid, q = id & 15, n = (id >> 4) & 63, g = id >> 10, chn = g * 64 + n;
            float ar, ai, fr, fi; s5_disc(P, chn, ar, ai, fr, fi);
            const float br = P.in[I_BRE][chn * 16 + q], bi = P.in[I_BIM][chn * 16 + q]; float wr = fr * br - fi * bi, wi = fr * bi + fi * br;
            bf16* G1 = (bf16*)(ws + WS_G1);
#pragma unroll
            for (int t = 0; t < 16; ++t) { const int i = 15 - t; G1[((size_t)(g * 128 + n)) * 256 + i * 16 + q] = (bf16)f2bf(wr); G1[((size_t)(g * 128 + 64 + n)) * 256 + i * 16 + q] = (bf16)f2bf(wi);
                const float nr = wr * ar - wi * ai, ni = wr * ai + wi * ar; wr = nr; wi = ni; }
        }
    }
}

template <bool FIRST> __device__ __forceinline__ void phase_norm(const Params& P, int layer, int which, int lane, int wave) {
    unsigned char* ws = P.ws; float* X = (float*)(ws + WS_X); bf16* H = (bf16*)(ws + WS_H);
    const float* g = P.in[I_NORMG] + (layer * 2 + which) * 1024; const float* MOD = (const float*)(ws + WS_MOD) + (size_t)layer * MODL;
    const int shoff = which ? 3 * 1024 : 0, scoff = which ? 4 * 1024 : 1024;
    const int gw = blockIdx.x * 8 + wave, NGW = gridDim.x * 8;
    for (int r = gw; r < MT; r += NGW) {
        u32x2* ho = (u32x2*)(H + (size_t)r * 1024) + lane;
        if (r >= MV) {
#pragma unroll
            for (int j = 0; j < 4; ++j) ho[64 * j] = (u32x2){0u, 0u};
            if (FIRST) { f32x4* xo = (f32x4*)(X + (size_t)r * 1024) + lane;
#pragma unroll
                for (int j = 0; j < 4; ++j) xo[64 * j] = (f32x4){0.f, 0.f, 0.f, 0.f}; }
            continue;
        }
        const float* src = FIRST ? (r < LP ? P.in[I_XP] + (size_t)r * 1024 : P.in[I_XS] + (size_t)(r - LP) * 1024) : X + (size_t)r * 1024;
        const f32x4* xr = (const f32x4*)src + lane;
        f32x4 v[4]; float ss = 0.f;
#pragma unroll
        for (int j = 0; j < 4; ++j) { v[j] = xr[64 * j]; ss += (v[j].x * v[j].x + v[j].y * v[j].y) + (v[j].z * v[j].z + v[j].w * v[j].w); }
        const float rstd = rsqrtf(wave_sum(ss) * (1.0f / 1024.0f) + EPS);
        const float* mod = MOD + (size_t)(r < LP ? 0 : r - LP + 1) * MODROW;
#pragma unroll
        for (int j = 0; j < 4; ++j) { const int col = 4 * (lane + 64 * j);
            const f32x4 gg = *(const f32x4*)(g + col), sc = *(const f32x4*)(mod + scoff + col), sh = *(const f32x4*)(mod + shoff + col);
            const f32x4 o = v[j] * rstd * gg * (sc + 1.0f) + sh;
            ho[64 * j] = (u32x2){pk2(o.x, o.y), pk2(o.z, o.w)};
            if (FIRST) ((f32x4*)(X + (size_t)r * 1024) + lane)[64 * j] = v[j]; }
    }
}
__device__ __forceinline__ void phase_final_norm(const Params& P, int lane, int wave) {
    const float* X = (const float*)(P.ws + WS_X); const float* g = P.in[I_FING];
    const int gw = blockIdx.x * 8 + wave, NGW = gridDim.x * 8;
    for (int r = gw; r < MV; r += NGW) {
        const f32x4* xr = (const f32x4*)(X + (size_t)r * 1024) + lane;
        f32x4 v[4]; float ss = 0.f;
#pragma unroll
        for (int j = 0; j < 4; ++j) { v[j] = xr[64 * j]; ss += (v[j].x * v[j].x + v[j].y * v[j].y) + (v[j].z * v[j].z + v[j].w * v[j].w); }
        const float rstd = rsqrtf(wave_sum(ss) * (1.0f / 1024.0f) + EPS);
        float* orow = r < LP ? P.out + O_YP + (size_t)r * 1024 : P.out + O_YS + (size_t)(r - LP) * 1024;
#pragma unroll
        for (int j = 0; j < 4; ++j) { const int col = 4 * (lane + 64 * j); const f32x4 gg = *(const f32x4*)(g + col); ((f32x4*)orow + lane)[64 * j] = v[j] * rstd * gg; }
    }
}

__device__ __forceinline__ void sgu_unit(const Params& P, LAS unsigned char* lds, int c, int h, int tid, int lane, int wave) {
    const bf16* PROJ = (const bf16*)(P.ws + WS_PROJ); bf16* MIX = (bf16*)(P.ws + WS_MIX);
    LAS unsigned char* vnb = lds;
    LAS unsigned char* wb = lds + 32768;
    LAS float* stat = (LAS float*)(lds + 65536);
    const int R0 = c * CH;
    { u32x4 wv[16];
#pragma unroll
      for (int rr = 0; rr < 16; ++rr) wv[rr] = *(const u32x4*)(PROJ + (size_t)(R0 + wave * 16 + rr) * EIN + 1024 + lane * 8);
#pragma unroll
      for (int rr = 0; rr < 16; ++rr) { const int row = wave * 16 + rr; float x[8]; unpack8(wv[rr], x);
        float s = 0.f;
#pragma unroll
        for (int k = 0; k < 8; ++k) s += x[k];
        const float mean = wave_sum(s) * (1.0f / 512.0f); float q = 0.f;
#pragma unroll
        for (int k = 0; k < 8; ++k) { const float d = x[k] - mean; q += d * d; }
        const float rstd = rsqrtf(wave_sum(q) * (1.0f / 512.0f) + EPS);
        if (lane == 0) { stat[row * 2] = mean; stat[row * 2 + 1] = rstd; } } }
    const float* sgw = P.in[I_SGW] + (size_t)h * 128 * 128;
#pragma unroll
    for (int it = 0; it < 8; ++it) { const int pc = tid + 512 * it, i = pc >> 5, j0 = (pc & 31) * 4; const f32x4 w4 = *(const f32x4*)(sgw + i * 128 + j0);
        const float a0 = j0 <= i ? w4.x : 0.f, a1 = j0 + 1 <= i ? w4.y : 0.f, a2 = j0 + 2 <= i ? w4.z : 0.f, a3 = j0 + 3 <= i ? w4.w : 0.f;
        *(LAS u32x2*)(wb + i * 256 + (((j0 >> 2) ^ ((i & 15) << 1)) * 8)) = (u32x2){pg8::cvt_pk_bf16(a0, a1), pg8::cvt_pk_bf16(a2, a3)}; }
    __syncthreads();
    const float* lng = P.in[I_LNG] + h * 128; const float* lnb = P.in[I_LNB] + h * 128;
#pragma unroll
    for (int it = 0; it < 4; ++it) { const int idx = tid + 512 * it, row = idx >> 4, e0 = (idx & 15) * 8;
        const u32x4 w = *(const u32x4*)(PROJ + (size_t)(R0 + row) * EIN + 1024 + h * 128 + e0); float x[8]; unpack8(w, x);
        const float mean = stat[row * 2], rstd = stat[row * 2 + 1]; float y[8];
#pragma unroll
        for (int k = 0; k < 8; ++k) y[k] = (x[k] - mean) * rstd * lng[e0 + k] + lnb[e0 + k];
        u32x4 o; o.x = pg8::cvt_pk_bf16(y[0], y[1]); o.y = pg8::cvt_pk_bf16(y[2], y[3]); o.z = pg8::cvt_pk_bf16(y[4], y[5]); o.w = pg8::cvt_pk_bf16(y[6], y[7]);
        *(LAS u32x4*)(vnb + (e0 >> 6) * 16384 + row * 128 + ((((e0 & 63) >> 3) ^ (row & 7)) * 16)) = o; }
    __syncthreads();
    const int g4 = lane >> 4, il = lane & 15;
    f32x4 acc[8];
#pragma unroll
    for (int nt = 0; nt < 8; ++nt) acc[nt] = (f32x4){0.f, 0.f, 0.f, 0.f};
    const int vr0 = 4 * g4 + (il >> 2), vx = vr0 & 7, vo = vr0 * 128 + 8 * (il & 1), vc = (il & 3) >> 1;
    const int npair = (wave + 2) >> 1;
    for (int kp = 0; kp < npair; ++kp) {
        const int ia = 16 * wave + il;
        const u32x2 a0 = *(const LAS u32x2*)(wb + ia * 256 + (((8 * kp + g4) ^ (il << 1)) * 8)), a1 = *(const LAS u32x2*)(wb + ia * 256 + (((8 * kp + 4 + g4) ^ (il << 1)) * 8));
        const bf16x8v af = __builtin_bit_cast(bf16x8v, (u32x4){a0.x, a0.y, a1.x, a1.y});
#pragma unroll
        for (int nt = 0; nt < 8; ++nt) { const LAS unsigned char* vb0 = vnb + (nt >> 2) * 16384 + (32 * kp) * 128; const int off = vo + (((2 * (nt & 3) + vc) ^ vx) * 16);
            const s16x4v va = __builtin_amdgcn_ds_read_tr16_b64_v4i16((LAS s16x4v*)(vb0 + off)), vb2 = __builtin_amdgcn_ds_read_tr16_b64_v4i16((LAS s16x4v*)(vb0 + 2048 + off));
            const bf16x8v bfg = (bf16x8v){va[0], va[1], va[2], va[3], vb2[0], vb2[1], vb2[2], vb2[3]};
            acc[nt] = __builtin_amdgcn_mfma_f32_16x16x32_bf16(af, bfg, acc[nt], 0, 0, 0); } }
    const float* sgb = P.in[I_SGB] + h * 128;
#pragma unroll
    for (int rg = 0; rg < 4; ++rg) { const int i = 16 * wave + 4 * g4 + rg; const size_t row = (size_t)(R0 + i); const float bi = sgb[i];
#pragma unroll
        for (int nt = 0; nt < 8; ++nt) { const int e = 16 * nt + il; const float uu = pg8::bf2f(PROJ[row * EIN + 512 + h * 128 + e]);
            MIX[row * 1024 + 512 + h * 128 + e] = (bf16)f2bf(uu * (acc[nt][rg] + bi)); } }
    __syncthreads();
}
__device__ __forceinline__ void sgu_sample(const Params& P, int lane, int wave) {
    const bf16* PROJ = (const bf16*)(P.ws + WS_PROJ); bf16* MIX = (bf16*)(P.ws + WS_MIX);
    for (int rr = 0; rr < 4; ++rr) { const int b = wave * 4 + rr; const size_t row = (size_t)(LP + b);
        const u32x4 w = *(const u32x4*)(PROJ + row * EIN + 1024 + lane * 8); float x[8]; unpack8(w, x);
        const u32x4 uw = *(const u32x4*)(PROJ + row * EIN + 512 + lane * 8); float uu[8]; unpack8(uw, uu);
        float s = 0.f;
#pragma unroll
        for (int k = 0; k < 8; ++k) s += x[k];
        const float mean = wave_sum(s) * (1.0f / 512.0f); float q = 0.f;
#pragma unroll
        for (int k = 0; k < 8; ++k) { const float d = x[k] - mean; q += d * d; }
        const float rstd = rsqrtf(wave_sum(q) * (1.0f / 512.0f) + EPS);
        const int col0 = lane * 8, hh = col0 >> 7; const float w00 = P.in[I_SGW][(size_t)hh * 128 * 128], b0 = P.in[I_SGB][hh * 128];
        float o[8];
#pragma unroll
        for (int k = 0; k < 8; ++k) { const float vn = (x[k] - mean) * rstd * P.in[I_LNG][col0 + k] + P.in[I_LNB][col0 + k]; P.out[O_SGUV + (size_t)b * 512 + col0 + k] = vn; o[k] = uu[k] * (w00 * vn + b0); }
        u32x4 ow; ow.x = pk2(o[0], o[1]); ow.y = pk2(o[2], o[3]); ow.z = pk2(o[4], o[5]); ow.w = pk2(o[6], o[7]);
        *(u32x4*)(MIX + row * 1024 + 512 + col0) = ow; }
}
__device__ __forceinline__ void s5_gemm1_unit(const Params& P, int g, int kt, int lane) {
    const bf16* PROJ = (const bf16*)(P.ws + WS_PROJ); const bf16* G1 = (const bf16*)(P.ws + WS_G1) + (size_t)g * 128 * 256; float* S = (float*)(P.ws + WS_SBUF) + (size_t)g * 128 * 1024;
    const int g4 = lane >> 4, kl = lane & 15, k0 = 16 * kt;
    bf16x8v bfr[8];
#pragma unroll
    for (int ks = 0; ks < 8; ++ks) bfr[ks] = *(const bf16x8v*)(PROJ + (size_t)(16 * (k0 + kl) + 2 * ks + (g4 >> 1)) * EIN + g * 16 + 8 * (g4 & 1));
    f32x4 acc[8];
#pragma unroll
    for (int mt = 0; mt < 8; ++mt) acc[mt] = (f32x4){0.f, 0.f, 0.f, 0.f};
#pragma unroll
    for (int ks = 0; ks < 8; ++ks)
#pragma unroll
        for (int mt = 0; mt < 8; ++mt) { const bf16x8v a = *(const bf16x8v*)(G1 + (size_t)(16 * mt + kl) * 256 + 32 * ks + 8 * g4); acc[mt] = __builtin_amdgcn_mfma_f32_16x16x32_bf16(a, bfr[ks], acc[mt], 0, 0, 0); }
#pragma unroll
    for (int mt = 0; mt < 8; ++mt)
#pragma unroll
        for (int rg = 0; rg < 4; ++rg) S[(size_t)(16 * mt + 4 * g4 + rg) * 1024 + k0 + kl] = acc[mt][rg];
}
__device__ __forceinline__ void s5_scan_unit(const Params& P, LAS unsigned char* lds, int g, int oct, int tid, int lane, int wave) {
    const int n = 8 * oct + wave, chn = g * 64 + n;
    const float* S = (const float*)(P.ws + WS_SBUF) + (size_t)g * 128 * 1024; const float* A2 = (const float*)(P.ws + WS_S5A);
    const float a16r = A2[4096 + 2 * chn], a16i = A2[4096 + 2 * chn + 1];
    float sr[16], si[16];
#pragma unroll
    for (int v = 0; v < 4; ++v) { const f32x4 x = *(const f32x4*)(S + (size_t)n * 1024 + 16 * lane + 4 * v), y = *(const f32x4*)(S + (size_t)(64 + n) * 1024 + 16 * lane + 4 * v);
#pragma unroll
        for (int e = 0; e < 4; ++e) { sr[4 * v + e] = x[e]; si[4 * v + e] = y[e]; } }
    float xr = 0.f, xi = 0.f;
#pragma unroll
    for (int kk = 0; kk < 16; ++kk) { const float nr = a16r * xr - a16i * xi + sr[kk], ni = a16r * xi + a16i * xr + si[kk]; xr = nr; xi = ni; }
    float mr = A2[8192 + 2 * chn], mi = A2[8192 + 2 * chn + 1];
#pragma unroll
    for (int d = 1; d < 64; d <<= 1) { const float vr = __shfl_up(xr, d), vi = __shfl_up(xi, d);
        if (lane >= d) { xr += mr * vr - mi * vi; xi += mr * vi + mi * vr; }
        const float nr = mr * mr - mi * mi, ni = 2.0f * mr * mi; mr = nr; mi = ni; }
    float hr = __shfl_up(xr, 1), hi = __shfl_up(xi, 1); if (lane == 0) { hr = 0.f; hi = 0.f; }
    LAS bf16* tile = (LAS bf16*)lds;
#pragma unroll
    for (int kk = 0; kk < 16; ++kk) { tile[(16 * lane + kk) * 16 + wave] = (bf16)f2bf(hr); tile[(16 * lane + kk) * 16 + 8 + wave] = (bf16)f2bf(hi);
        const float nr = a16r * hr - a16i * hi + sr[kk], ni = a16r * hi + a16i * hr + si[kk]; hr = nr; hi = ni; }
    if (lane == 63) { P.out[O_S5RP + chn] = hr; P.out[O_S5IP + chn] = hi; }
    __syncthreads();
    bf16* HC = (bf16*)(P.ws + WS_HCAT) + (size_t)g * 1024 * 128;
#pragma unroll
    for (int it = 0; it < 4; ++it) { const int pc = tid + 512 * it, k = pc >> 1, hf = pc & 1;
        *(u32x4*)(HC + (size_t)k * 128 + 64 * hf + 8 * oct) = *(const LAS u32x4*)(lds + k * 32 + 16 * hf); }
    __syncthreads();
}
__device__ __forceinline__ void s5_gemm3_unit(const Params& P, int g, int kt, int lane) {
    const bf16* PROJ = (const bf16*)(P.ws + WS_PROJ); bf16* Y = (bf16*)(P.ws + WS_Y);
    const bf16* KT = (const bf16*)(P.ws + WS_KTAB) + (size_t)g * 4096; const bf16* ET = (const bf16*)(P.ws + WS_ETAB) + (size_t)g * 32768; const bf16* HC = (const bf16*)(P.ws + WS_HCAT) + (size_t)g * 1024 * 128;
    const int g4 = lane >> 4, kl = lane & 15, k0 = 16 * kt;
    bf16x8v bfr[8], hfr[4];
#pragma unroll
    for (int ks = 0; ks < 8; ++ks) bfr[ks] = *(const bf16x8v*)(PROJ + (size_t)(16 * (k0 + kl) + 2 * ks + (g4 >> 1)) * EIN + g * 16 + 8 * (g4 & 1));
#pragma unroll
    for (int ks = 0; ks < 4; ++ks) hfr[ks] = *(const bf16x8v*)(HC + (size_t)(k0 + kl) * 128 + 32 * ks + 8 * g4);
    const bf16x8v zero8 = (bf16x8v){0, 0, 0, 0, 0, 0, 0, 0};
#pragma unroll
    for (int j = 0; j < 16; ++j) { f32x4 acc = (f32x4){0.f, 0.f, 0.f, 0.f};
#pragma unroll
        for (int ks = 0; ks <= (j >> 1); ++ks) { const int tau = j - 2 * ks - (g4 >> 1);
            bf16x8v a = *(const bf16x8v*)(KT + (size_t)((tau < 0 ? 0 : tau) * 16 + kl) * 16 + 8 * (g4 & 1)); if (tau < 0) a = zero8;
            acc = __builtin_amdgcn_mfma_f32_16x16x32_bf16(a, bfr[ks], acc, 0, 0, 0); }
#pragma unroll
        for (int ks = 0; ks < 4; ++ks) { const bf16x8v a = *(const bf16x8v*)(ET + (size_t)(j * 16 + kl) * 128 + 32 * ks + 8 * g4); acc = __builtin_amdgcn_mfma_f32_16x16x32_bf16(a, hfr[ks], acc, 0, 0, 0); }
        *(u32x2*)(Y + (size_t)(16 * (k0 + kl) + j) * 512 + g * 16 + 4 * g4) = (u32x2){pg8::cvt_pk_bf16(gelu_t(acc[0]), gelu_t(acc[1])), pg8::cvt_pk_bf16(gelu_t(acc[2]), gelu_t(acc[3]))}; }
}
__device__ __forceinline__ void s5_sample_unit(const Params& P, int b, int g, int lane) {
    const bf16* PROJ = (const bf16*)(P.ws + WS_PROJ); bf16* Y = (bf16*)(P.ws + WS_Y);
    const int chn = g * 64 + lane; const float* BB = (const float*)(P.ws + WS_S5BB) + (size_t)chn * 32; const float* A2 = (const float*)(P.ws + WS_S5A);
    const float ar = A2[2 * chn], ai = A2[2 * chn + 1];
    const size_t row = (size_t)(LP + b); const bf16* up = PROJ + row * EIN + g * 16;
    const u32x4 w0 = *(const u32x4*)up, w1 = *(const u32x4*)(up + 8); float u[16];
    { float a[8], bq[8]; unpack8(w0, a); unpack8(w1, bq);
#pragma unroll
      for (int k = 0; k < 8; ++k) { u[k] = a[k]; u[8 + k] = bq[k]; } }
    float br = 0.f, bi = 0.f;
#pragma unroll
    for (int p = 0; p < 16; ++p) { br += BB[p] * u[p]; bi += BB[16 + p] * u[p]; }
    const float h0r = P.in[I_S5RE][(size_t)b * 2048 + chn], h0i = P.in[I_S5IM][(size_t)b * 2048 + chn];
    const float hr = ar * h0r - ai * h0i + br, hi = ar * h0i + ai * h0r + bi;
    P.out[O_S5RS + (size_t)b * 2048 + chn] = hr; P.out[O_S5IS + (size_t)b * 2048 + chn] = hi;
    float ymine = 0.f;
#pragma unroll
    for (int p = 0; p < 16; ++p) { const float v = P.in[I_CRE][(size_t)(g * 16 + p) * 64 + lane] * hr - P.in[I_CIM][(size_t)(g * 16 + p) * 64 + lane] * hi; const float s = wave_sum(v); if (lane == p) ymine = s + P.in[I_S5D][g * 16 + p] * u[p]; }
    if (lane < 16) Y[row * 512 + g * 16 + lane] = (bf16)f2bf(gelu_t(ymine));
}

__device__ __forceinline__ void phase_conv(const Params& P, int layer, int tid) {
    const bf16* UP = (const bf16*)(P.ws + WS_UP); bf16* ACT = (bf16*)(P.ws + WS_ACT);
    const float* cw = P.in[I_CONVW] + (size_t)layer * 3 * DFF; const float* cb = P.in[I_CONVB] + (size_t)layer * DFF;
    const float* st = P.in[I_CONV] + (size_t)layer * NS * 2 * DFF;
    const float* HEAD = (const float*)(P.ws + WS_HEAD); const float* TAIL = (const float*)(P.ws + WS_TAIL);
    constexpr int NSEG = DFF / 8;
    const int gt = blockIdx.x * 512 + tid, GT = gridDim.x * 512;
    for (int it = gt; it < 63 * 2 * (DFF / 4); it += GT) {
        const int c0 = (it % (DFF / 4)) * 4, fr = (it / (DFF / 4)) & 1, pm = 1 + it / (2 * (DFF / 4));
        const f32x4 a0 = *(const f32x4*)(HEAD + ((size_t)(pm * 2 + fr) * 2) * DFF + c0), gg = *(const f32x4*)(HEAD + ((size_t)(pm * 2 + fr) * 2 + 1) * DFF + c0);
        const f32x4 t0 = *(const f32x4*)(TAIL + (size_t)((pm - 1) * 2) * DFF + c0), t1 = *(const f32x4*)(TAIL + (size_t)((pm - 1) * 2 + 1) * DFF + c0);
        const f32x4 h0 = *(const f32x4*)(HEAD + ((size_t)(pm * 2) * 2) * DFF + c0);
        const f32x4 a1 = fr == 1 ? h0 : t1, a2 = fr == 1 ? t1 : t0;
        const f32x4 w0 = *(const f32x4*)(cw + c0), w1 = *(const f32x4*)(cw + DFF + c0), w2 = *(const f32x4*)(cw + 2 * DFF + c0), bb = *(const f32x4*)(cb + c0);
        float o[4];
#pragma unroll
        for (int e = 0; e < 4; ++e) o[e] = gelu_t(bb[e] + w0[e] * a2[e] + w1[e] * a1[e] + w2[e] * a0[e]) * gg[e];
        *(u32x2*)(ACT + (size_t)(256 * pm + fr) * DFF + c0) = (u32x2){pg8::cvt_pk_bf16(o[0], o[1]), pg8::cvt_pk_bf16(o[2], o[3])};
    }
    for (int it = gt; it < 2 * (DFF / 4); it += GT) { const int c0 = (it % (DFF / 4)) * 4, rr = it / (DFF / 4);
        *(f32x4*)(P.out + O_CONVP + ((size_t)layer * 2 + rr) * DFF + c0) = *(const f32x4*)(TAIL + (size_t)(63 * 2 + rr) * DFF + c0); }
    for (int it = gt; it < NS * NSEG; it += GT) {
        const int b = it / NSEG, c0 = (it % NSEG) * 8, r = LP + b; float a0[8], gg[8], o[8];
        unpack8(*(const u32x4*)(UP + (size_t)r * UPN + c0), a0); unpack8(*(const u32x4*)(UP + (size_t)r * UPN + DFF + c0), gg);
        float* op = P.out + O_CONVS + (((size_t)layer * NS + b) * 2) * DFF + c0;
#pragma unroll
        for (int k = 0; k < 8; ++k) { const float a2 = st[((size_t)b * 2 + 0) * DFF + c0 + k], a1 = st[((size_t)b * 2 + 1) * DFF + c0 + k];
            const float y = cb[c0 + k] + cw[c0 + k] * a2 + cw[DFF + c0 + k] * a1 + cw[2 * DFF + c0 + k] * a0[k]; o[k] = gelu_t(y) * gg[k]; op[k] = a1; op[DFF + k] = a0[k]; }
        u32x4 ow; ow.x = pg8::cvt_pk_bf16(o[0], o[1]); ow.y = pg8::cvt_pk_bf16(o[2], o[3]); ow.z = pg8::cvt_pk_bf16(o[4], o[5]); ow.w = pg8::cvt_pk_bf16(o[6], o[7]);
        *(u32x4*)(ACT + (size_t)r * DFF + c0) = ow;
    }
}

__device__ __forceinline__ void phase_rope(const Params& P, int tid) {
    bf16* QKV = (bf16*)(P.ws + WS_QKV);
    const float inv[8] = {1.0f, 0.1939227432012558f, 0.03760603070259094f, 0.007292664609849453f, 0.0014142135623842478f, 0.00027424818836152554f, 5.318296098266728e-05f, 1.0313386155758053e-05f};
    const long total = (long)MV * 16;
    for (long it = (long)blockIdx.x * 512 + tid; it < total; it += (long)gridDim.x * 512) {
        const int r = (int)(it >> 4), h = (int)(it & 15); const float pos = (float)(r < LP ? r : 16384);
        float cs[8], sn[8];
#pragma unroll
        for (int i = 0; i < 8; ++i) sincos_red(pos * inv[i], sn[i], cs[i]);
#pragma unroll
        for (int which = 0; which < 2; ++which) { bf16* p = QKV + (size_t)r * QKVN + which * 1024 + h * 64;
            float x1[8], x2[8]; unpack8(*(const u32x4*)p, x1); unpack8(*(const u32x4*)(p + 8), x2); float o1[8], o2[8];
#pragma unroll
            for (int i = 0; i < 8; ++i) { o1[i] = x1[i] * cs[i] - x2[i] * sn[i]; o2[i] = x1[i] * sn[i] + x2[i] * cs[i]; }
            u32x4 w1, w2; w1.x = pk2(o1[0], o1[1]); w1.y = pk2(o1[2], o1[3]); w1.z = pk2(o1[4], o1[5]); w1.w = pk2(o1[6], o1[7]);
            w2.x = pk2(o2[0], o2[1]); w2.y = pk2(o2[2], o2[3]); w2.z = pk2(o2[4], o2[5]); w2.w = pk2(o2[6], o2[7]);
            *(u32x4*)p = w1; *(u32x4*)(p + 8) = w2;
            if (which == 1 && (r >= LP - 2048)) {
                float* ko = r < LP ? P.out + O_KP + ((size_t)(r - (LP - 2048)) * 16 + h) * 64 : P.out + O_KS + ((size_t)(r - LP) * 16 + h) * 64;
#pragma unroll
                for (int i = 0; i < 8; ++i) { ko[i] = o1[i]; ko[8 + i] = o2[i]; }
#pragma unroll
                for (int j = 2; j < 8; ++j) { float x[8]; unpack8(*(const u32x4*)(p + 8 * j), x);
#pragma unroll
                    for (int i = 0; i < 8; ++i) ko[8 * j + i] = x[i]; } } }
        if (r >= LP - 2048) { const bf16* p = QKV + (size_t)r * QKVN + 2048 + h * 64;
            float* vo = r < LP ? P.out + O_VP + ((size_t)(r - (LP - 2048)) * 16 + h) * 64 : P.out + O_VS + ((size_t)(r - LP) * 16 + h) * 64;
#pragma unroll
            for (int j = 0; j < 8; ++j) { float x[8]; unpack8(*(const u32x4*)(p + 8 * j), x);
#pragma unroll
                for (int i = 0; i < 8; ++i) vo[8 * j + i] = x[i]; } }
    }
}

__device__ __forceinline__ void attn_stage_glds(const bf16* QKV, LAS unsigned char* buf, int h, int C0, int lane, int wave) {
#pragma unroll
    for (int t = 0; t < 4; ++t) { const int row = (4 * wave + t) * 8 + (lane >> 3), ch = (lane & 7) ^ (lane >> 3), x = 16 * (row & 15) + (row >> 4);
        const bf16* src = QKV + (size_t)(C0 + x) * QKVN + 1024 + h * 64 + ch * 8;
        __builtin_amdgcn_global_load_lds((const unsigned*)src, (LAS unsigned*)(buf + (4 * wave + t) * 1024), 16, 0, 0);
        __builtin_amdgcn_global_load_lds((const unsigned*)(src + 1024), (LAS unsigned*)(buf + 32768 + (4 * wave + t) * 1024), 16, 0, 0); }
}
__device__ __forceinline__ float xmax4(float v) {
    auto a = __builtin_amdgcn_permlane32_swap(__float_as_uint(v), __float_as_uint(v), false, false); v = fmaxf(__uint_as_float(a[0]), __uint_as_float(a[1]));
    auto b = __builtin_amdgcn_permlane16_swap(__float_as_uint(v), __float_as_uint(v), false, false); return fmaxf(__uint_as_float(b[0]), __uint_as_float(b[1]));
}
__device__ __forceinline__ float xsum4(float v) {
    auto a = __builtin_amdgcn_permlane32_swap(__float_as_uint(v), __float_as_uint(v), false, false); v = __uint_as_float(a[0]) + __uint_as_float(a[1]);
    auto b = __builtin_amdgcn_permlane16_swap(__float_as_uint(v), __float_as_uint(v), false, false); return __uint_as_float(b[0]) + __uint_as_float(b[1]);
}
__device__ __forceinline__ float lgmask(unsigned ud, unsigned A, unsigned B, unsigned C) { return ud <= A ? (ud <= B ? (ud <= C ? 1.5849625007f : 1.0f) : 0.f) : -1e30f; }

template <int NT> __device__ __forceinline__ void attn_softmax_pv(f32x4 (&s)[NT], const LAS unsigned char* const (&vb)[NT], int lane, f32x4 (&o)[4], float& m, float& l) {
    const int q = lane >> 4, i = lane & 15;
    float smax = -1e30f;
#pragma unroll
    for (int k = 0; k < NT; ++k) smax = fmaxf(fmaxf(smax, fmaxf(s[k][0], s[k][1])), fmaxf(s[k][2], s[k][3]));
    smax = xmax4(smax);
    if (__any(smax > m)) { const float mn = fmaxf(m, smax), sc = __builtin_amdgcn_exp2f(m - mn);
#pragma unroll
        for (int mt = 0; mt < 4; ++mt) o[mt] = o[mt] * sc;
        l *= sc; m = mn; }
    const int vr0 = 4 * q + (i >> 2), vx = vr0 & 7, vo = vr0 * 128 + 8 * (i & 1), vc = (i & 3) >> 1;
    float ls = 0.f;
    if constexpr (NT >= 2) {
#pragma unroll
        for (int k = 0; k < NT; k += 2) {
            float p[8];
#pragma unroll
            for (int rg = 0; rg < 4; ++rg) { p[rg] = __builtin_amdgcn_exp2f(s[k][rg] - m); p[4 + rg] = __builtin_amdgcn_exp2f(s[k + 1][rg] - m); }
            ls += ((p[0] + p[1]) + (p[2] + p[3])) + ((p[4] + p[5]) + (p[6] + p[7]));
            u32x4 pw; pw.x = pg8::cvt_pk_bf16(p[0], p[1]); pw.y = pg8::cvt_pk_bf16(p[2], p[3]); pw.z = pg8::cvt_pk_bf16(p[4], p[5]); pw.w = pg8::cvt_pk_bf16(p[6], p[7]);
            const bf16x8v pf = __builtin_bit_cast(bf16x8v, pw);
#pragma unroll
            for (int mt = 0; mt < 4; ++mt) { const int off = vo + (((2 * mt + vc) ^ vx) * 16);
                const s16x4v va = __builtin_amdgcn_ds_read_tr16_b64_v4i16((LAS s16x4v*)(vb[k] + off)), vb2 = __builtin_amdgcn_ds_read_tr16_b64_v4i16((LAS s16x4v*)(vb[k + 1] + off));
                const bf16x8v vf = (bf16x8v){va[0], va[1], va[2], va[3], vb2[0], vb2[1], vb2[2], vb2[3]};
                o[mt] = __builtin_amdgcn_mfma_f32_16x16x32_bf16(vf, pf, o[mt], 0, 0, 0); } }
    } else {
        float p[4];
#pragma unroll
        for (int rg = 0; rg < 4; ++rg) p[rg] = __builtin_amdgcn_exp2f(s[0][rg] - m);
        ls += (p[0] + p[1]) + (p[2] + p[3]);
        u32x2 pw; pw.x = pg8::cvt_pk_bf16(p[0], p[1]); pw.y = pg8::cvt_pk_bf16(p[2], p[3]);
        const s16x4v pf = __builtin_bit_cast(s16x4v, pw);
#pragma unroll
        for (int mt = 0; mt < 4; ++mt) { const int off = vo + (((2 * mt + vc) ^ vx) * 16);
            const s16x4v vf = __builtin_amdgcn_ds_read_tr16_b64_v4i16((LAS s16x4v*)(vb[0] + off));
            o[mt] = __builtin_amdgcn_mfma_f32_16x16x16bf16_1k(vf, pf, o[mt], 0, 0, 0); }
    }
    l += ls;
}
template <int NT, int CSTEP> __device__ __forceinline__ void attn_near_batch(const LAS unsigned char* buf, int cc0, int dbase, int r, int lane, const bf16x8v (&qf)[2], f32x4 (&o)[4], float& m, float& l) {
    const int q = lane >> 4, i = lane & 15;
    f32x4 s[NT]; const LAS unsigned char* vb[NT];
#pragma unroll
    for (int k = 0; k < NT; ++k) { const int cc = cc0 + k * CSTEP, krow = cc * 16 + i, kx = krow & 7; const LAS unsigned char* kb = buf + krow * 128;
        const bf16x8v k0 = *(const LAS bf16x8v*)(kb + ((q ^ kx) << 4)), k1 = *(const LAS bf16x8v*)(kb + (((q + 4) ^ kx) << 4));
        f32x4 z = (f32x4){0.f, 0.f, 0.f, 0.f};
        z = __builtin_amdgcn_mfma_f32_16x16x32_bf16(k0, qf[0], z, 0, 0, 0);
        s[k] = __builtin_amdgcn_mfma_f32_16x16x32_bf16(k1, qf[1], z, 0, 0, 0);
        vb[k] = buf + 32768 + cc * 2048; }
    const int dq = 16 * (dbase + i - 4 * q);
#pragma unroll
    for (int k = 0; k < NT; ++k) { const int cc = cc0 + k * CSTEP, e = r - cc;
        const unsigned A = e == 0 ? 2048u : ((e & 3) == 0 ? 512u : 128u), B = e == 0 ? 512u : ((e & 3) == 0 ? 128u : 0u), C = e == 0 ? 128u : 0u;
#pragma unroll
        for (int rg = 0; rg < 4; ++rg) s[k][rg] += lgmask((unsigned)(dq - 16 * rg + e), A, B, C); }
    attn_softmax_pv<NT>(s, vb, lane, o, m, l);
}
__device__ __forceinline__ void attn_far_batch(const bf16* QKV, LAS unsigned char* priv, int h, int T0, int c0, int c_first, int r, int lane, const bf16x8v (&qf)[2], f32x4 (&o)[4], float& m, float& l) {
    const int q = lane >> 4, i = lane & 15;
    bf16x8v kf[3][2]; u32x4 vp[3][2];
#pragma unroll
    for (int k = 0; k < 3; ++k) { const int c = c0 + k; const bool ex = c >= c_first; const int C0 = ex ? T0 - 2048 + 256 * c : T0;
        const bf16* kp = QKV + (size_t)(C0 + 16 * i + r) * QKVN + 1024 + h * 64 + 8 * q;
        kf[k][0] = *(const bf16x8v*)kp; kf[k][1] = *(const bf16x8v*)(kp + 32);
#pragma unroll
        for (int t = 0; t < 2; ++t) { const int pc = lane + 64 * t, jp = pc >> 3, ch = pc & 7; vp[k][t] = *(const u32x4*)(QKV + (size_t)(C0 + 16 * jp + r) * QKVN + 2048 + h * 64 + ch * 8); } }
    f32x4 s[3]; const LAS unsigned char* vb[4];
#pragma unroll
    for (int k = 0; k < 3; ++k) {
#pragma unroll
        for (int t = 0; t < 2; ++t) { const int pc = lane + 64 * t, jp = pc >> 3, ch = pc & 7; *(LAS u32x4*)(priv + k * 2048 + jp * 128 + ((ch ^ (jp & 7)) * 16)) = vp[k][t]; }
        f32x4 z = (f32x4){0.f, 0.f, 0.f, 0.f};
        z = __builtin_amdgcn_mfma_f32_16x16x32_bf16(kf[k][0], qf[0], z, 0, 0, 0);
        s[k] = __builtin_amdgcn_mfma_f32_16x16x32_bf16(kf[k][1], qf[1], z, 0, 0, 0);
        vb[k] = priv + k * 2048; }
    f32x4 s4[4];
#pragma unroll
    for (int k = 0; k < 3; ++k) { const int c = c0 + k; const unsigned A = c >= c_first ? 2048u : 0u; const int dq = 16 * (16 * (8 - c) + i - 4 * q);
#pragma unroll
        for (int rg = 0; rg < 4; ++rg) s4[k][rg] = s[k][rg] + lgmask((unsigned)(dq - 16 * rg), A, 512u, 128u); }
    s4[3] = (f32x4){-1e30f, -1e30f, -1e30f, -1e30f}; vb[3] = priv;
    attn_softmax_pv<4>(s4, vb, lane, o, m, l);
}
__device__ __forceinline__ void attn_prompt_unit(const Params& P, LAS unsigned char* lds, int h, int tb, int tid, int lane, int wave) {
    const bf16* QKV = (const bf16*)(P.ws + WS_QKV); bf16* ATT = (bf16*)(P.ws + WS_ATT);
    const int T0 = tb * 256, q = lane >> 4, i = lane & 15;
    bf16x8v qf[2][2]; f32x4 o[2][4]; float m[2], l[2];
    const float qs = 0.125f * 1.4426950408889634f;
#pragma unroll
    for (int u = 0; u < 2; ++u) { const int t = T0 + 16 * i + wave + 8 * u;
#pragma unroll
        for (int ks = 0; ks < 2; ++ks) { const u32x4 w = *(const u32x4*)(QKV + (size_t)t * QKVN + h * 64 + 32 * ks + 8 * q); float x[8]; unpack8(w, x);
            u32x4 ww; ww.x = pg8::cvt_pk_bf16(x[0] * qs, x[1] * qs); ww.y = pg8::cvt_pk_bf16(x[2] * qs, x[3] * qs); ww.z = pg8::cvt_pk_bf16(x[4] * qs, x[5] * qs); ww.w = pg8::cvt_pk_bf16(x[6] * qs, x[7] * qs);
            qf[u][ks] = __builtin_bit_cast(bf16x8v, ww); }
#pragma unroll
        for (int mt = 0; mt < 4; ++mt) o[u][mt] = (f32x4){0.f, 0.f, 0.f, 0.f};
        m[u] = -1e29f; l[u] = 0.f; }
    const int c_first = tb >= 8 ? 0 : 8 - tb;
    const int cn0 = c_first > 6 ? c_first : 6;
    attn_stage_glds(QKV, lds + ((cn0 & 1) ? 65536 : 0), h, T0 - 2048 + 256 * cn0, lane, wave);
    if (c_first < 6) {
        LAS unsigned char* priv = lds + ((cn0 & 1) ? 0 : 65536) + wave * 8192;
#pragma unroll
        for (int u = 0; u < 2; ++u) { const int r = wave + 8 * u;
            if (c_first < 3) attn_far_batch(QKV, priv, h, T0, 0, c_first, r, lane, qf[u], o[u], m[u], l[u]);
            attn_far_batch(QKV, priv, h, T0, 3, c_first, r, lane, qf[u], o[u], m[u], l[u]); }
    }
    asm volatile("s_waitcnt vmcnt(0)" ::: "memory");
    __syncthreads();
    for (int c = cn0; c <= 8; ++c) {
        const LAS unsigned char* buf = lds + ((c & 1) ? 65536 : 0);
        if (c < 8) attn_stage_glds(QKV, lds + (((c + 1) & 1) ? 65536 : 0), h, T0 - 2048 + 256 * (c + 1), lane, wave);
        const int dbase = 16 * (8 - c);
#pragma unroll
        for (int u = 0; u < 2; ++u) { const int r = wave + 8 * u;
            if (c == 6) attn_near_batch<4, 4>(buf, r & 3, dbase, r, lane, qf[u], o[u], m[u], l[u]);
            else { attn_near_batch<8, 1>(buf, 0, dbase, r, lane, qf[u], o[u], m[u], l[u]); attn_near_batch<8, 1>(buf, 8, dbase, r, lane, qf[u], o[u], m[u], l[u]); } }
        asm volatile("s_waitcnt vmcnt(0)" ::: "memory");
        __syncthreads();
    }
#pragma unroll
    for (int u = 0; u < 2; ++u) { const float il = 1.0f / xsum4(l[u]);
        const int t = T0 + 16 * i + wave + 8 * u; bf16* op = ATT + (size_t)t * 1024 + h * 64 + 4 * q;
#pragma unroll
        for (int mt = 0; mt < 4; ++mt) { const f32x4 v = o[u][mt] * il; *(u32x2*)(op + 16 * mt) = (u32x2){pg8::cvt_pk_bf16(v[0], v[1]), pg8::cvt_pk_bf16(v[2], v[3])}; } }
}
__device__ __forceinline__ const float* attn_sample_row(const float* cache, const float* newrow, int b, int h, int j) {
    const int br = j / 129, k = j - br * 129, idx = 2048 - (k << (2 * br));
    return idx == 2048 ? newrow + ((size_t)b * 16 + h) * 64 : cache + (((size_t)b * 2048 + idx) * 16 + h) * 64;
}
__device__ __forceinline__ void attn_sample_unit(const Params& P, LAS unsigned char* lds, int su, int lane, int wave) {
    const bf16* QKV = (const bf16*)(P.ws + WS_QKV); bf16* ATT = (bf16*)(P.ws + WS_ATT);
    const int unit = 2 * su + (wave >> 2), b = unit >> 4, h = unit & 15, part = wave & 3, nk = part < 3 ? 97 : 96;
    const size_t row = (size_t)(LP + b);
    LAS float* pw = (LAS float*)(lds + wave * 512);
    LAS float* pm = (LAS float*)(lds + 4096);
    LAS float* pl = pm + 8;
    LAS float* po = (LAS float*)(lds + 4608);
    float q[64];
    { const bf16* qp = QKV + row * QKVN + h * 64;
#pragma unroll
      for (int j = 0; j < 8; ++j) { float x[8]; unpack8(*(const u32x4*)(qp + 8 * j), x);
#pragma unroll
          for (int i = 0; i < 8; ++i) q[8 * j + i] = x[i] * 0.125f; } }
    const float* CK = P.in[I_CK]; const float* CV = P.in[I_CV]; const float* KN = P.out + O_KS; const float* VN = P.out + O_VS;
    float mx = -1e30f; float sv[2];
#pragma unroll
    for (int i = 0; i < 2; ++i) { const int jj = lane + 64 * i; float s = -1e30f;
        if (jj < nk) { const f32x4* kp = (const f32x4*)attn_sample_row(CK, KN, b, h, part + 4 * jj); s = 0.f;
#pragma unroll
            for (int e = 0; e < 16; ++e) { const f32x4 x = kp[e]; s += (q[4 * e] * x.x + q[4 * e + 1] * x.y) + (q[4 * e + 2] * x.z + q[4 * e + 3] * x.w); } }
        sv[i] = s; mx = fmaxf(mx, s); }
    mx = wave_max(mx); float ls = 0.f;
#pragma unroll
    for (int i = 0; i < 2; ++i) { const int jj = lane + 64 * i; const float p = (jj < nk) ? __expf(sv[i] - mx) : 0.f; ls += p; pw[jj] = p; }
    ls = wave_sum(ls);
    asm volatile("s_waitcnt lgkmcnt(0)" ::: "memory");
    float o0 = 0.f, o1 = 0.f, o2 = 0.f, o3 = 0.f;
    for (int jj = 0; jj < 96; jj += 4) {
        const float v0 = attn_sample_row(CV, VN, b, h, part + 4 * jj)[lane], v1 = attn_sample_row(CV, VN, b, h, part + 4 * (jj + 1))[lane];
        const float v2 = attn_sample_row(CV, VN, b, h, part + 4 * (jj + 2))[lane], v3 = attn_sample_row(CV, VN, b, h, part + 4 * (jj + 3))[lane];
        o0 += pw[jj] * v0; o1 += pw[jj + 1] * v1; o2 += pw[jj + 2] * v2; o3 += pw[jj + 3] * v3; }
    if (nk == 97) o0 += pw[96] * attn_sample_row(CV, VN, b, h, part + 4 * 96)[lane];
    po[wave * 64 + lane] = (o0 + o1) + (o2 + o3); if (lane == 0) { pm[wave] = mx; pl[wave] = ls; }
    __syncthreads();
    if (part == 0) { const int w0 = wave; float M = fmaxf(fmaxf(pm[w0], pm[w0 + 1]), fmaxf(pm[w0 + 2], pm[w0 + 3])); float L = 0.f, o = 0.f;
#pragma unroll
        for (int k = 0; k < 4; ++k) { const float f = __expf(pm[w0 + k] - M); L += f * pl[w0 + k]; o += f * po[(w0 + k) * 64 + lane]; }
        ATT[row * 1024 + h * 64 + lane] = (bf16)f2bf(o / L); }
    __syncthreads();
}

typedef float f32x16 __attribute__((ext_vector_type(16)));
struct SEpiStore { bf16* O; int ldc; int gelu_from;
    __device__ __forceinline__ void apply(int b, int c, float v) const { O[(size_t)(LP + b) * ldc + c] = (bf16)f2bf(c >= gelu_from ? gelu_t(v) : v); } };
struct SEpiUp { bf16* O; int ldc;
    __device__ __forceinline__ void apply(int b, int c, float v) const { const int t = c >> 8, x = c & 255; const int cs = x < 128 ? 128 * t + x : DFF + 128 * t + x - 128; O[(size_t)(LP + b) * ldc + cs] = (bf16)f2bf(v); } };
struct SEpiGlu { bf16* O; int ldc; const bf16* Y; int ldy; const float* bias;
    __device__ __forceinline__ void apply(int b, int c, float v) const { const float y = pg8::bf2f(Y[(size_t)(LP + b) * ldy + c]); O[(size_t)(LP + b) * ldc + c] = (bf16)f2bf(y * pg8::sigmoidf_(v + bias[c])); } };
struct SEpiResid { float* X; const float* gate; int gstride;
    __device__ __forceinline__ void apply(int b, int c, float v) const { float* xp = X + (size_t)(LP + b) * 1024 + c; *xp = *xp + gate[(size_t)(b + 1) * gstride + c] * v; } };
template <class Epi> __device__ __forceinline__ void sample_gemm_units(LAS unsigned char* lds, const bf16* A, int lda, const bf16* Bt, int N, int K, const Epi& E, int tid, int lane, int wave, int G, int bx) {
    const int nun = N / 32, r = lane & 31, hh = lane >> 5, kw = K / 8;
    for (int su = G - 1 - bx; su < nun; su += G) {
        const int n0 = su * 32;
        f32x16 acc;
#pragma unroll
        for (int e = 0; e < 16; ++e) acc[e] = 0.f;
        const bf16* ap = A + (size_t)(LP + r) * lda + wave * kw + 8 * hh;
        const bf16* bp = Bt + (size_t)(n0 + r) * K + wave * kw + 8 * hh;
#pragma unroll 4
        for (int ks = 0; ks < kw / 16; ++ks) { const bf16x8v a = *(const bf16x8v*)(ap + 16 * ks), b = *(const bf16x8v*)(bp + 16 * ks); acc = __builtin_amdgcn_mfma_f32_32x32x16_bf16(a, b, acc, 0, 0, 0); }
        LAS float* red = (LAS float*)lds;
#pragma unroll
        for (int e = 0; e < 16; ++e) red[wave * 1056 + ((e & 3) + 8 * (e >> 2) + 4 * hh) * 33 + r] = acc[e];
        __syncthreads();
        for (int o = tid; o < 1024; o += 512) { const int row = o >> 5, col = o & 31; float v = 0.f;
#pragma unroll
            for (int w = 0; w < 8; ++w) v += red[w * 1056 + row * 33 + col];
            E.apply(row, n0 + col, v); }
        __syncthreads();
    }
}

#define XB_TMO      128
#define XB_XCNT(j)  (256  + 64 * (j))
#define XB_XSUB(j)  (1280 + 64 * (j))
#define XB_XGEN(j)  (2304 + 64 * (j))
#define XB_TOP      3328
#define XB_TOPGEN   3392
#define XCD_BAR_WORDS 3456
#define XB_SPIN_CAP (1u << 18)

__device__ __forceinline__ unsigned xb_ld(unsigned* p)              { return __hip_atomic_load(p, __ATOMIC_RELAXED, __HIP_MEMORY_SCOPE_AGENT); }
__device__ __forceinline__ unsigned xb_add(unsigned* p, unsigned v) { return __hip_atomic_fetch_add(p, v, __ATOMIC_RELAXED, __HIP_MEMORY_SCOPE_AGENT); }
__device__ __forceinline__ unsigned xb_xcc_id() { return (unsigned)__builtin_amdgcn_s_getreg((3 << 11) | 20) & 0xFu; }
#define XB_SPIN(cond, bar) do { unsigned _sp = 0; while (cond) { __builtin_amdgcn_s_sleep(1); \
    if ((++_sp & 255u) == 0u) { if (xb_ld(&(bar)[XB_TMO])) break; if (_sp > XB_SPIN_CAP) { atomicAdd(&(bar)[XB_TMO], 1u); break; } } } } while (0)

struct XcdBarrier {
    unsigned* bar; unsigned x;
    volatile LAS unsigned* st;
};

__device__ __forceinline__ XcdBarrier xcd_barrier_post(unsigned* bar, volatile LAS unsigned* st) {
    XcdBarrier b; b.bar = bar; b.x = xb_xcc_id(); b.st = st;
    if (threadIdx.x == 0) (void)xb_add(&bar[XB_XCNT(b.x)], 1u);
    return b;
}
__device__ __forceinline__ void xcd_barrier_complete(unsigned* bar, unsigned x, unsigned& nloc, unsigned& nx) {
    const unsigned G = gridDim.x * gridDim.y * gridDim.z;
    unsigned sum, cnt, mine, sp = 0u;
    for (;;) {
        sum = 0u; cnt = 0u; mine = 0u;
#pragma unroll
        for (unsigned j = 0; j < 16; ++j) { const unsigned c = xb_ld(&bar[XB_XCNT(j)]); sum += c; cnt += (c > 0u) ? 1u : 0u; mine = (j == x) ? c : mine; }
        if (sum == G) break;
        __builtin_amdgcn_s_sleep(1);
        if ((++sp & 255u) == 0u) { if (xb_ld(&bar[XB_TMO])) break; if (sp > XB_SPIN_CAP) { atomicAdd(&bar[XB_TMO], 1u); break; } }
    }
    nloc = mine > 0u ? mine : 1u; nx = cnt > 0u ? cnt : 1u;
}

__device__ __forceinline__ void xcd_barrier(const XcdBarrier& b) {
    asm volatile("s_waitcnt vmcnt(0)" ::: "memory");
    __syncthreads();
    if (threadIdx.x == 0) {
        unsigned* bar = b.bar;
        __builtin_amdgcn_s_waitcnt(0);
        unsigned nloc = b.st[0], nx = b.st[1];
        if (nloc == 0u) { xcd_barrier_complete(bar, b.x, nloc, nx); b.st[0] = nloc; b.st[1] = nx; }
        const unsigned old = xb_add(&bar[XB_XSUB(b.x)], 1u);
        const unsigned gen = old / nloc;
        if (old + 1u == (gen + 1u) * nloc) {
            __builtin_amdgcn_fence(__ATOMIC_RELEASE, "agent");
            asm volatile("s_waitcnt vmcnt(0)" ::: "memory");
            const unsigned og = xb_add(&bar[XB_TOP], 1u);
            const unsigned tg = og / nx;
            if (og + 1u == (tg + 1u) * nx) xb_add(&bar[XB_TOPGEN], 1u);
            else XB_SPIN(xb_ld(&bar[XB_TOPGEN]) == tg, bar);
            __builtin_amdgcn_fence(__ATOMIC_ACQUIRE, "agent");
            xb_add(&bar[XB_XGEN(b.x)], 1u);
            asm volatile("s_waitcnt vmcnt(0)" ::: "memory");
        } else {
            XB_SPIN(xb_ld(&bar[XB_XGEN(b.x)]) == gen, bar);
            __builtin_amdgcn_fence(__ATOMIC_ACQUIRE, "agent");
            asm volatile("s_waitcnt vmcnt(0)" ::: "memory");
        }
    }
    __syncthreads();
}

__global__ void __launch_bounds__(512, 2) mega_fwd(Params P) {
    extern __shared__ __attribute__((aligned(16))) unsigned char lds_raw[];
    LAS unsigned char* lds = (LAS unsigned char*)lds_raw;
    const int tid = threadIdx.x, lane = tid & 63, wave = __builtin_amdgcn_readfirstlane(tid >> 6);
    const int G = gridDim.x, bx = blockIdx.x;
    unsigned char* ws = P.ws;
    const int lo = P.ph_lo, hi = P.ph_hi;
    cg::grid_group grid = cg::this_grid();
    volatile LAS unsigned* bst = (volatile LAS unsigned*)(lds + LDS_BYTES - 64);
    if (tid < 16) bst[tid] = 0u;
    __syncthreads();
    XcdBarrier bar = xcd_barrier_post((unsigned*)(ws + WS_CTL) + 4096, bst);
#ifndef PHASE_MASK
#define PHASE_MASK 0xffffffffu
#endif
#define IN(k) (((PHASE_MASK >> (k)) & 1u) && lo <= (k) && (k) < hi)
#ifndef REPMASK
#define REPMASK 0u
#endif
#ifndef REPN
#define REPN 1
#endif
#define REPLOOP(k) for (int rep_ = 0, nrep_ = 1 + (((REPMASK >> (k)) & 1u) ? REPN : 0); rep_ < nrep_; (++rep_ < nrep_) ? xcd_barrier(bar) : (void)0)
#define SEAM(k) do { if (IN(k) && IN((k) + 1)) { if ((k) == 0) grid.sync(); else xcd_barrier(bar); } } while (0)
#define GEMM_PHASE(EPI, Aoff, Boff, Mm, Nn, Kk, Eobj) do { pg8::Gemm g_{(const bf16*)(ws + (Aoff)), (const bf16*)(ws + (Boff)), (Mm), (Nn), (Kk)}; pg8::StaticOrder S_; S_.init((Mm), (Nn), G, bx); \
        pg8::gemm_phase<EPI, pg8::StaticOrder, true, true>(lds, g_, S_, Eobj); } while (0)

    if (IN(0)) REPLOOP(0) { phase_prep(P, lds, tid, lane, wave); } SEAM(0);
    if (IN(1)) REPLOOP(1) { phase_norm<true>(P, 0, 0, lane, wave); } SEAM(1);
    if (IN(2)) REPLOOP(2) { pg8::EpiStore E{(bf16*)(ws + WS_PROJ), EIN, 512}; GEMM_PHASE(pg8::EpiStore, WS_H, WS_WIN, LP, EIN, 1024, E);
        SEpiStore SE{(bf16*)(ws + WS_PROJ), EIN, 512}; sample_gemm_units(lds, (const bf16*)(ws + WS_H), 1024, (const bf16*)(ws + WS_WIN), EIN, 1024, SE, tid, lane, wave, G, bx); } SEAM(2);
    if (IN(3)) REPLOOP(3) {
        const int NSGU = NCH * 4, NG1 = NG * 64 / 8, NS5S = NS * NG / 8, NU = NSGU + 1 + NG1 + NS5S;
        for (int u = bx; u < NU; u += G) {
            if (u < NSGU) sgu_unit(P, lds, u >> 2, u & 3, tid, lane, wave);
            else if (u == NSGU) sgu_sample(P, lane, wave);
            else if (u < NSGU + 1 + NG1) { const int wu = (u - NSGU - 1) * 8 + wave; s5_gemm1_unit(P, wu >> 6, wu & 63, lane); }
            else { const int wu = (u - NSGU - 1 - NG1) * 8 + wave; s5_sample_unit(P, wu >> 5, wu & 31, lane); }
        }
    } SEAM(3);
    if (IN(4)) REPLOOP(4) { for (int u = bx; u < NG * 8; u += G) s5_scan_unit(P, lds, u >> 3, u & 7, tid, lane, wave); } SEAM(4);
    if (IN(5)) REPLOOP(5) { for (int wu = bx * 8 + wave; wu < NG * 64; wu += G * 8) s5_gemm3_unit(P, wu >> 6, wu & 63, lane); } SEAM(5);
    if (IN(6)) REPLOOP(6) { pg8::EpiGlu E{(bf16*)(ws + WS_MIX), 1024, (const bf16*)(ws + WS_Y), 512, P.in[I_BGLU]}; GEMM_PHASE(pg8::EpiGlu, WS_Y, WS_WGLU, LP, 512, 512, E);
        SEpiGlu SE{(bf16*)(ws + WS_MIX), 1024, (const bf16*)(ws + WS_Y), 512, P.in[I_BGLU]}; sample_gemm_units(lds, (const bf16*)(ws + WS_Y), 512, (const bf16*)(ws + WS_WGLU), 512, 512, SE, tid, lane, wave, G, bx); } SEAM(6);
    if (IN(7)) REPLOOP(7) { pg8::EpiResid E{(float*)(ws + WS_X), (const float*)(ws + WS_MOD) + 2 * 1024, MODROW, LP, MV}; GEMM_PHASE(pg8::EpiResid, WS_MIX, WS_WOUT, LP, 1024, 1024, E);
        SEpiResid SE{(float*)(ws + WS_X), (const float*)(ws + WS_MOD) + 2 * 1024, MODROW}; sample_gemm_units(lds, (const bf16*)(ws + WS_MIX), 1024, (const bf16*)(ws + WS_WOUT), 1024, 1024, SE, tid, lane, wave, G, bx); } SEAM(7);
    if (IN(8)) REPLOOP(8) { phase_norm<false>(P, 0, 1, lane, wave); } SEAM(8);
    if (IN(9)) REPLOOP(9) { pg8::EpiUpConv E{(bf16*)(ws + WS_ACT), DFF, P.in[I_CONVW] + (size_t)0 * 3 * DFF, P.in[I_CONVB] + (size_t)0 * DFF, DFF, (float*)(ws + WS_HEAD), (float*)(ws + WS_TAIL), (LAS float*)(lds + 131072)};
        GEMM_PHASE(pg8::EpiUpConv, WS_H, WS_WUP0, LP, UPN, 1024, E);
        SEpiUp SE{(bf16*)(ws + WS_UP), UPN}; sample_gemm_units(lds, (const bf16*)(ws + WS_H), 1024, (const bf16*)(ws + WS_WUP0), UPN, 1024, SE, tid, lane, wave, G, bx); } SEAM(9);
    if (IN(10)) REPLOOP(10) { phase_conv(P, 0, tid); } SEAM(10);
    if (IN(11)) REPLOOP(11) { pg8::EpiResid E{(float*)(ws + WS_X), (const float*)(ws + WS_MOD) + 5 * 1024, MODROW, LP, MV}; GEMM_PHASE(pg8::EpiResid, WS_ACT, WS_WDN0, LP, 1024, DFF, E);
        SEpiResid SE{(float*)(ws + WS_X), (const float*)(ws + WS_MOD) + 5 * 1024, MODROW}; sample_gemm_units(lds, (const bf16*)(ws + WS_ACT), DFF, (const bf16*)(ws + WS_WDN0), 1024, DFF, SE, tid, lane, wave, G, bx); } SEAM(11);
    if (IN(12)) REPLOOP(12) { phase_norm<false>(P, 1, 0, lane, wave); } SEAM(12);
    if (IN(13)) REPLOOP(13) { pg8::EpiStore E{(bf16*)(ws + WS_QKV), QKVN, 1 << 30}; GEMM_PHASE(pg8::EpiStore, WS_H, WS_WQKV, LP, QKVN, 1024, E);
        SEpiStore SE{(bf16*)(ws + WS_QKV), QKVN, 1 << 30}; sample_gemm_units(lds, (const bf16*)(ws + WS_H), 1024, (const bf16*)(ws + WS_WQKV), QKVN, 1024, SE, tid, lane, wave, G, bx); } SEAM(13);
    if (IN(14)) REPLOOP(14) { phase_rope(P, tid); } SEAM(14);
    if (IN(15)) REPLOOP(15) {
        const int NPU = 16 * (LP / 256), NSU = NS * 16 / 2;
        for (int u = bx; u < NSU; u += G) attn_sample_unit(P, lds, u, lane, wave);
        for (int u = bx; u < NPU; u += G) { int hh, tb; if ((G & 7) == 0 && NPU % G == 0) { const int x = u & 7, li = (u % G) >> 3, rho = u / G, per = G >> 3;
                const int idx = rho * per + li; hh = 2 * x + (idx & 1); tb = idx >> 1; } else { hh = u & 15; tb = u >> 4; }
            attn_prompt_unit(P, lds, hh, tb, tid, lane, wave); }
    } SEAM(15);
    if (IN(16)) REPLOOP(16) { pg8::EpiResid E{(float*)(ws + WS_X), (const float*)(ws + WS_MOD) + MODL + 2 * 1024, MODROW, LP, MV}; GEMM_PHASE(pg8::EpiResid, WS_ATT, WS_WO, LP, 1024, 1024, E);
        SEpiResid SE{(float*)(ws + WS_X), (const float*)(ws + WS_MOD) + MODL + 2 * 1024, MODROW}; sample_gemm_units(lds, (const bf16*)(ws + WS_ATT), 1024, (const bf16*)(ws + WS_WO), 1024, 1024, SE, tid, lane, wave, G, bx); } SEAM(16);
    if (IN(17)) REPLOOP(17) { phase_norm<false>(P, 1, 1, lane, wave); } SEAM(17);
    if (IN(18)) REPLOOP(18) { pg8::EpiUpConv E{(bf16*)(ws + WS_ACT), DFF, P.in[I_CONVW] + (size_t)1 * 3 * DFF, P.in[I_CONVB] + (size_t)1 * DFF, DFF, (float*)(ws + WS_HEAD), (float*)(ws + WS_TAIL), (LAS float*)(lds + 131072)};
        GEMM_PHASE(pg8::EpiUpConv, WS_H, WS_WUP1, LP, UPN, 1024, E);
        SEpiUp SE{(bf16*)(ws + WS_UP), UPN}; sample_gemm_units(lds, (const bf16*)(ws + WS_H), 1024, (const bf16*)(ws + WS_WUP1), UPN, 1024, SE, tid, lane, wave, G, bx); } SEAM(18);
    if (IN(19)) REPLOOP(19) { phase_conv(P, 1, tid); } SEAM(19);
    if (IN(20)) REPLOOP(20) { pg8::EpiResid E{(float*)(ws + WS_X), (const float*)(ws + WS_MOD) + MODL + 5 * 1024, MODROW, LP, MV}; GEMM_PHASE(pg8::EpiResid, WS_ACT, WS_WDN1, LP, 1024, DFF, E);
        SEpiResid SE{(float*)(ws + WS_X), (const float*)(ws + WS_MOD) + MODL + 5 * 1024, MODROW}; sample_gemm_units(lds, (const bf16*)(ws + WS_ACT), DFF, (const bf16*)(ws + WS_WDN1), 1024, DFF, SE, tid, lane, wave, G, bx); } SEAM(20);
    if (IN(21)) REPLOOP(21) { phase_final_norm(P, lane, wave); }
#undef IN
#undef SEAM
#undef GEMM_PHASE
}

#ifndef N_LAUNCH_MODE
#define N_LAUNCH_MODE 1
#endif
extern "C" void kernel_launch(void* const* d_in, const int* in_sizes, int n_in, void* d_out, int out_size, void* d_ws, size_t ws_size, hipStream_t stream) {
    static int grid = 0;
    if (grid == 0) {
        if (n_in != N_IN || out_size != (int)O_TOTAL || ws_size < WS_END) { fprintf(stderr, "kernel_launch: unexpected shapes (n_in %d, out %d, ws %zu)\n", n_in, out_size, ws_size); grid = -1; return; }
        int dev = 0, cus = 0, per_cu = 0;
        if (hipGetDevice(&dev) != hipSuccess || hipDeviceGetAttribute(&cus, hipDeviceAttributeMultiprocessorCount, dev) != hipSuccess) { grid = -1; return; }
        if (hipFuncSetAttribute((const void*)mega_fwd, hipFuncAttributeMaxDynamicSharedMemorySize, LDS_BYTES) != hipSuccess) { fprintf(stderr, "kernel_launch: hipFuncSetAttribute failed\n"); grid = -1; return; }
        if (hipOccupancyMaxActiveBlocksPerMultiprocessor(&per_cu, (const void*)mega_fwd, 512, LDS_BYTES) != hipSuccess || per_cu < 1) { fprintf(stderr, "kernel_launch: occupancy query says %d\n", per_cu); per_cu = 1; }
        (void)hipGetLastError();
        grid = cus;
    }
    if (grid < 0) return;
    if (hipMemsetAsync((char*)d_ws + WS_CTL, 0, 1 * MiB, stream) != hipSuccess) { fprintf(stderr, "kernel_launch: memset failed\n"); return; }
    Params p{};
    for (int i = 0; i < N_IN; ++i) p.in[i] = (const float*)d_in[i];
    p.out = (float*)d_out; p.ws = (unsigned char*)d_ws;
#if N_LAUNCH_MODE == 1
    p.ph_lo = 0; p.ph_hi = NPHASE;
    void* args[] = {&p};
    hipError_t e = hipLaunchCooperativeKernel((const void*)mega_fwd, dim3(grid), dim3(512), args, LDS_BYTES, stream);
    if (e != hipSuccess) fprintf(stderr, "kernel_launch: cooperative launch failed: %s (grid %d)\n", hipGetErrorString(e), grid);
#else
    for (int ph = 0; ph < NPHASE; ++ph) { p.ph_lo = ph; p.ph_hi = ph + 1; hipLaunchKernelGGL(mega_fwd, dim3(grid), dim3(512), LDS_BYTES, stream, p); }
#endif
}
```
